# Optimizing an MI355X kernel written in HIP

```python
import math
import jax, jax.numpy as jnp
from jax import lax
import numpy as np

D_MODEL = 2048
BATCH = 4
SEQ = 4096
DEPTH = 4

N_MIXERS = 2
N_RET_LAYERS = (DEPTH + 1) // 2
N_POOL_LAYERS = DEPTH // 2
EPS = 1e-6

N_RET_HEADS = 8
RET_QK_DIM = D_MODEL
RET_V_DIM = 2 * D_MODEL
RET_HEAD_QK = RET_QK_DIM // N_RET_HEADS
RET_HEAD_V = RET_V_DIM // N_RET_HEADS
RET_GATE_DIM = RET_V_DIM
RET_IN_COLS = 2 * RET_QK_DIM + RET_V_DIM + RET_GATE_DIM
RET_CHUNK = 128
ROPE_BASE = 10000.0

POOL_WIDTH = 2 * D_MODEL
POOL_WINDOWS = (2, 4, 8, 16)
POOL_GROUPS = len(POOL_WINDOWS)
POOL_GROUP_DIM = POOL_WIDTH // POOL_GROUPS

kernel_name = "hybrid_retention_pooling_gated"


def rms_norm(x, g):
    xf = x.astype(jnp.float32)
    y = xf * lax.rsqrt(jnp.mean(xf * xf, axis=-1, keepdims=True) + EPS)
    return (y * g.astype(jnp.float32)).astype(x.dtype)


def rope(x, seq_len):
    d = x.shape[-1]
    half = d // 2
    inv = ROPE_BASE ** (-jnp.arange(half, dtype=jnp.float32) / half)
    ang = jnp.arange(seq_len, dtype=jnp.float32)[:, None] * inv[None, :]
    cos = jnp.cos(ang)[None, :, None, :]
    sin = jnp.sin(ang)[None, :, None, :]
    x1, x2 = x[..., :half], x[..., half:]
    return jnp.concatenate([x1 * cos - x2 * sin, x1 * sin + x2 * cos], axis=-1)


def retention_log_decay():
    h = jnp.arange(N_RET_HEADS, dtype=jnp.float32)
    return jnp.log1p(-jnp.exp2(-5.0 - h))


def chunkwise_retention(q, k, v):
    B, S, H, dk = q.shape
    dv = v.shape[-1]
    C = RET_CHUNK
    NC = S // C
    lg = retention_log_decay()
    idx = jnp.arange(C, dtype=jnp.float32)
    diff = idx[:, None] - idx[None, :]
    mask = jnp.where(diff[None] >= 0,
                     jnp.exp(jnp.maximum(diff, 0.0)[None] * lg[:, None, None]), 0.0)
    q_decay = jnp.exp((idx[None, :] + 1.0) * lg[:, None])
    k_decay = jnp.exp((C - 1.0 - idx[None, :]) * lg[:, None])
    chunk_decay = jnp.exp(C * lg)

    def to_chunks(t):
        return t.reshape(B, NC, C, H, t.shape[-1]).transpose(1, 0, 3, 2, 4)

    qc, kc, vc = to_chunks(q), to_chunks(k), to_chunks(v)

    def body(state, inp):
        qi, ki, vi = inp
        scores = jnp.einsum('bhid,bhjd->bhij', qi, ki) * mask[None]
        inner = jnp.einsum('bhij,bhje->bhie', scores, vi)
        cross = jnp.einsum('bhid,bhde->bhie', qi * q_decay[None, :, :, None], state)
        new_state = (chunk_decay[None, :, None, None] * state
                     + jnp.einsum('bhjd,bhje->bhde', ki * k_decay[None, :, :, None], vi))
        return new_state, inner + cross

    state0 = jnp.zeros((B, H, dk, dv), jnp.float32)
    _, out = lax.scan(body, state0, (qc, kc, vc))
    return out.transpose(1, 0, 3, 2, 4).reshape(B, S, H, dv)


def retention_layer(x, g_norm, w_in, gn, w_out):
    B, S, _ = x.shape
    h = rms_norm(x, g_norm)
    p = h @ w_in
    q, k, v, z = jnp.split(p, [RET_QK_DIM, 2 * RET_QK_DIM, 2 * RET_QK_DIM + RET_V_DIM], axis=-1)
    q = rope(q.astype(jnp.float32).reshape(B, S, N_RET_HEADS, RET_HEAD_QK), S)
    k = rope(k.astype(jnp.float32).reshape(B, S, N_RET_HEADS, RET_HEAD_QK), S) * (RET_HEAD_QK ** -0.5)
    v = v.astype(jnp.float32).reshape(B, S, N_RET_HEADS, RET_HEAD_V)
    o = chunkwise_retention(q, k, v)
    mu = jnp.mean(o, axis=-1, keepdims=True)
    var = jnp.mean(jnp.square(o - mu), axis=-1, keepdims=True)
    o = ((o - mu) * lax.rsqrt(var + EPS)).reshape(B, S, RET_V_DIM) * gn.astype(jnp.float32)
    o = o.astype(x.dtype) * jax.nn.silu(z)
    return o @ w_out


def pooling_layer(x, g_norm, w_in, w_grp, b_grp, scale, w_out):
    B, S, _ = x.shape
    h = rms_norm(x, g_norm)
    p = h @ w_in
    u, z = jnp.split(p, [POOL_WIDTH], axis=-1)
    u = u.reshape(B, S, POOL_GROUPS, POOL_GROUP_DIM)
    uf = u.astype(jnp.float32)
    cs = jnp.concatenate([jnp.zeros((B, 1, POOL_GROUPS, POOL_GROUP_DIM), jnp.float32),
                          jnp.cumsum(uf, axis=1)], axis=1)
    t = jnp.arange(S)
    pooled = []
    for gi, w in enumerate(POOL_WINDOWS):
        lo = jnp.maximum(t + 1 - w, 0)
        cnt = jnp.minimum(t + 1, w).astype(jnp.float32)[None, :, None]
        win_sum = cs[:, 1:, gi] - jnp.take(cs[:, :, gi], lo, axis=1)
        pooled.append(win_sum / cnt)
    pooled = jnp.stack(pooled, axis=2)
    mix = (pooled - uf).astype(x.dtype)
    mix = jnp.einsum('bsgc,gcd->bsgd', mix, w_grp) + b_grp
    mix = mix.reshape(B, S, POOL_WIDTH) * scale
    return (mix * jax.nn.silu(z)) @ w_out


def setup_inputs(seed: int = 0) -> dict:
    key = jax.random.key(seed)
    ks = jax.random.split(key, 13)
    f32 = jnp.float32
    nr, npl = N_RET_LAYERS, N_POOL_LAYERS
    return {
        "x": jax.random.normal(ks[0], (BATCH, SEQ, D_MODEL), f32),
        "ret_norm": 1.0 + 0.05 * jax.random.normal(ks[1], (nr, D_MODEL), f32),
        "ret_w_in": jax.random.normal(ks[2], (nr, D_MODEL, RET_IN_COLS), f32) * D_MODEL ** -0.5,
        "ret_gn": 1.0 + 0.05 * jax.random.normal(ks[3], (nr, RET_V_DIM), f32),
        "ret_w_out": jax.random.normal(ks[4], (nr, RET_V_DIM, D_MODEL), f32) * RET_V_DIM ** -0.5,
        "pool_norm": 1.0 + 0.05 * jax.random.normal(ks[5], (npl, D_MODEL), f32),
        "pool_w_in": jax.random.normal(ks[6], (npl, D_MODEL, 2 * POOL_WIDTH), f32) * D_MODEL ** -0.5,
        "pool_w_grp": jax.random.normal(ks[7], (npl, POOL_GROUPS, POOL_GROUP_DIM, POOL_GROUP_DIM), f32) * POOL_GROUP_DIM ** -0.5,
        "pool_b_grp": 0.01 * jax.random.normal(ks[8], (npl, POOL_GROUPS, POOL_GROUP_DIM), f32),
        "pool_scale": 1.0 + 0.1 * jax.random.normal(ks[9], (npl, POOL_WIDTH), f32),
        "pool_w_out": jax.random.normal(ks[10], (npl, POOL_WIDTH, D_MODEL), f32) * POOL_WIDTH ** -0.5,
        "final_norm": 1.0 + 0.05 * jax.random.normal(ks[11], (D_MODEL,), f32),
    }


def reference(x, ret_norm, ret_w_in, ret_gn, ret_w_out, pool_norm, pool_w_in,
              pool_w_grp, pool_b_grp, pool_scale, pool_w_out, final_norm):
    h = x
    for i in range(DEPTH):
        j = i // N_MIXERS
        if i % N_MIXERS == 0:
            h = h + retention_layer(h, ret_norm[j], ret_w_in[j], ret_gn[j], ret_w_out[j])
        else:
            h = h + pooling_layer(h, pool_norm[j], pool_w_in[j], pool_w_grp[j],
                                  pool_b_grp[j], pool_scale[j], pool_w_out[j])
    return rms_norm(h, final_norm)
```

```cpp
#include <hip/hip_runtime.h>
#include <stdint.h>
#include <stdio.h>

typedef unsigned short bf16;
typedef short bf16x8 __attribute__((ext_vector_type(8)));
typedef float f32x4 __attribute__((ext_vector_type(4)));
typedef unsigned u32x4 __attribute__((ext_vector_type(4)));
typedef unsigned u32x2 __attribute__((ext_vector_type(2)));
#define LAS __attribute__((address_space(3)))

constexpr int BATCH = 4, SEQ = 4096, D = 2048, M = BATCH * SEQ;
constexpr int NH = 8, HQK = 256, HV = 512, RQK = 2048, RV = 4096, RIN = 12288;
constexpr int PW = 4096, PG = 4, PGD = 1024, PIN = 8192;
constexpr int PINP = PIN + 128;
constexpr float EPS = 1e-6f;

constexpr size_t MiB = (size_t)1 << 20;
constexpr size_t WS_CTL = 0, CTL_BYTES = 1 * MiB;
constexpr size_t WS_COS = 1 * MiB, WS_SIN = 3 * MiB;
constexpr size_t WS_STEP = 15 * MiB;
constexpr size_t WS_RP = 5 * MiB;
constexpr size_t RP_STRIDE = 2 * MiB;
constexpr size_t WS_W_RIN = 16 * MiB, WS_W_ROUT = 112 * MiB, WS_W_PIN = 144 * MiB, WS_W_PGRP = 208 * MiB, WS_W_POUT = 224 * MiB;
constexpr size_t WS_HB = 256 * MiB;
constexpr size_t WS_P = 320 * MiB;
constexpr size_t WS_MIX = 584 * MiB;
constexpr size_t WS_ST = 720 * MiB;
constexpr size_t WS_END = 768 * MiB;

__device__ __forceinline__ unsigned f2bf(float f) { unsigned u = __builtin_bit_cast(unsigned, f); return (u + 0x7fffu + ((u >> 16) & 1u)) >> 16; }
__device__ __forceinline__ unsigned pk2(float lo, float hi) { return f2bf(lo) | (f2bf(hi) << 16); }
__device__ __forceinline__ float bf2f(unsigned b) { return __builtin_bit_cast(float, b << 16); }
__device__ __forceinline__ float silu(float z) { return z / (1.0f + __expf(-z)); }
__device__ __forceinline__ float wave_sum(float v) {
#pragma unroll
    for (int o = 1; o < 64; o <<= 1) v += __shfl_xor(v, o);
    return v;
}

__device__ __forceinline__ void transpose_item(const float* W, int K, int N, bf16* WT, LAS float* scr, int item, int lane) {
    const int nblk = N / 32, kb = item / nblk, nb = item % nblk, k0 = 64 * kb, n0 = 32 * nb;
    f32x4 wv[8];
#pragma unroll
    for (int i = 0; i < 8; ++i) wv[i] = *(const f32x4*)(W + (size_t)(k0 + 8 * i + (lane >> 3)) * N + n0 + 4 * (lane & 7));
#pragma unroll
    for (int i = 0; i < 8; ++i) { LAS float* d = scr + (8 * i + (lane >> 3)) * 33 + 4 * (lane & 7); d[0] = wv[i].x; d[1] = wv[i].y; d[2] = wv[i].z; d[3] = wv[i].w; }
    asm volatile("s_waitcnt lgkmcnt(0)" ::: "memory");
    const int c = lane & 7;
#pragma unroll
    for (int j = 0; j < 4; ++j) { const int n = (lane >> 3) + 8 * j; const LAS float* s = scr + (8 * c) * 33 + n;
        u32x4 o; o.x = pk2(s[0 * 33], s[1 * 33]); o.y = pk2(s[2 * 33], s[3 * 33]); o.z = pk2(s[4 * 33], s[5 * 33]); o.w = pk2(s[6 * 33], s[7 * 33]);
        *(u32x4*)(WT + (size_t)(n0 + n) * K + k0 + 8 * c) = o; }
    asm volatile("s_waitcnt lgkmcnt(0)" ::: "memory");
}

namespace pg8 {
#define PG8_LAS __attribute__((address_space(3)))
constexpr int BM = 256, BK = 64, HALF = 128, HTB = HALF * BK * 2  , STAGE_BYTES = 8 * HTB, NXCD = 8, WGM = 8;
__host__ __device__ __forceinline__ int lds_byte(int r, int c) { const int st = (r >> 4) * 2 + (c >> 5), rr = r & 15, cc = c & 31, ob = rr * 64 + cc * 2; return st * 1024 + (ob ^ (((ob >> 9) & 1) << 5)); }
__host__ __device__ __forceinline__ void stage_rc(int b, int& R, int& C) { const int st = b / 1024, sb = b % 1024, swz = sb ^ (((sb >> 9) & 1) << 5); R = (st >> 1) * 16 + swz / 64; C = (st & 1) * 32 + (swz % 64) / 2; }
__host__ __device__ __forceinline__ int perm32(int rho) { const int n = rho >> 4, i = rho & 15; return 8 * (i >> 2) + 4 * n + (i & 3); }

struct Unit { int pm, pn; };
struct Gemm { const bf16* A; const bf16* Bt; int M, N, K, lda, ldb, grp_tiles, grp_koff; };

struct StaticOrder {
    int nM, nN, nwg, G, c;
    __host__ __device__ void init(int M, int N, int G_, int c_) { nM = M / BM; nN = N / BM; nwg = nM * nN; G = G_; c = c_; }
    __host__ __device__ bool next(int i, Unit& u) const {
        const long L = (long)i * G + c; if (L >= nwg) return false;
        int wgid = (int)L; { const int q = nwg / NXCD, r = nwg % NXCD, xcd = wgid % NXCD, off = wgid / NXCD; wgid = (xcd < r ? xcd * (q + 1) : r * (q + 1) + (xcd - r) * q) + off; }
        const int nig = WGM * nN, gid = wgid / nig, fm = gid * WGM, gsz = (nM - fm) < WGM ? (nM - fm) : WGM;
        u.pm = fm + ((wgid % nig) % gsz); u.pn = (wgid % nig) / gsz; return true;
    }
};

typedef float f32x2 __attribute__((ext_vector_type(2)));
typedef __bf16 bf16x2_t __attribute__((ext_vector_type(2)));
__device__ __forceinline__ unsigned cvt_pk_bf16(float lo, float hi) { const f32x2 v = {lo, hi}; return __builtin_bit_cast(unsigned, __builtin_convertvector(v, bf16x2_t)); }
__device__ __forceinline__ u32x4 pack8(const f32x4 v0, const f32x4 v1) { u32x4 w; w.x = cvt_pk_bf16(v0[0], v0[1]); w.y = cvt_pk_bf16(v0[2], v0[3]); w.z = cvt_pk_bf16(v1[0], v1[1]); w.w = cvt_pk_bf16(v1[2], v1[3]); return w; }
__device__ __forceinline__ float row_rstd(const float* rp, int row, int fq) {
    const f32x4* p = (const f32x4*)(rp + (size_t)row * 32 + 8 * fq); const f32x4 a = p[0], b = p[1];
    float s = ((a.x + a.y) + (a.z + a.w)) + ((b.x + b.y) + (b.z + b.w));
    s += __shfl_xor(s, 16); s += __shfl_xor(s, 32);
    return 1.0f / sqrtf(s * (1.0f / (float)D) + EPS);
}
__device__ __forceinline__ u32x4 ror8(const u32x4 v) { u32x4 r;
#pragma unroll
    for (int j = 0; j < 4; ++j) r[j] = (unsigned)__builtin_amdgcn_update_dpp(0, (int)v[j], 0x128, 0xf, 0xf, false);
    return r; }
__device__ __forceinline__ void xchg8(bool lo, const u32x4 a, const u32x4 b, u32x4& o0, u32x4& o1) { const u32x4 y = ror8(lo ? b : a); o0 = lo ? a : y; o1 = lo ? y : b; }
__device__ __forceinline__ f32x4 silu4(const f32x4 z) { f32x4 r;
#pragma unroll
    for (int j = 0; j < 4; ++j) r[j] = z[j] * __builtin_amdgcn_rcpf(1.0f + __expf(-z[j]));
    return r; }
__device__ __forceinline__ f32x4 bf4lo(unsigned a, unsigned b) { return (f32x4){bf2f(a & 0xffffu), bf2f(a >> 16), bf2f(b & 0xffffu), bf2f(b >> 16)}; }

struct EpiRetIn {
    static constexpr bool PERM = true, BMAP = false;
    static constexpr bool NEED_RSTD = true;
    unsigned char* ws; const float* rp;
    __device__ __forceinline__ void operator()(const f32x4 (&acc)[2][2][4][2], const Unit& u, int wr, int wc, int fr, int fq, const PG8_LAS float* rsl) const {
        const int row0 = u.pm * BM + wr * 64 + fr, colw = wc * 32 + 8 * fq;
        const int kind = u.pn < 8 ? 0 : (u.pn < 16 ? 1 : 2);
        bf16* pbase = (bf16*)(ws + WS_P) + (size_t)(u.pn >> 4) * ((size_t)M * RV) + (u.pn & 15) * BM + colw;
        const float* cosT = (const float*)(ws + WS_COS); const float* sinT = (const float*)(ws + WS_SIN); const float* stepT = (const float*)(ws + WS_STEP);
        if (kind < 2) {
            const float ks = kind == 1 ? 0.0625f : 1.0f;
            f32x4 c[2][2], s[2][2];
#pragma unroll
            for (int ai = 0; ai < 2; ++ai) { const int sp = (row0 + ai * HALF) & (SEQ - 1);
                const f32x4* cp = (const f32x4*)(cosT + sp * 128 + colw); const f32x4* sq = (const f32x4*)(sinT + sp * 128 + colw);
                c[ai][0] = cp[0]; c[ai][1] = cp[1]; s[ai][0] = sq[0]; s[ai][1] = sq[1]; }
            const f32x4 dc0 = *(const f32x4*)(stepT + colw), dc1 = *(const f32x4*)(stepT + colw + 4), ds0 = *(const f32x4*)(stepT + 128 + colw), ds1 = *(const f32x4*)(stepT + 128 + colw + 4);
#pragma unroll
            for (int ai = 0; ai < 2; ++ai) {
                f32x4 c0 = c[ai][0], c1 = c[ai][1], s0 = s[ai][0], s1 = s[ai][1];
#pragma unroll
                for (int m = 0; m < 4; ++m) {
                    const float r1 = rsl[wr * 64 + fr + ai * HALF + m * 16] * ks; bf16* op = pbase + (size_t)(row0 + ai * HALF + m * 16) * RV;
                    const f32x4 a0 = acc[ai][0][m][0] * r1, a1 = acc[ai][0][m][1] * r1, b0 = acc[ai][1][m][0] * r1, b1 = acc[ai][1][m][1] * r1;
                    *(u32x4*)op = pack8(a0 * c0 - b0 * s0, a1 * c1 - b1 * s1);
                    *(u32x4*)(op + HALF) = pack8(a0 * s0 + b0 * c0, a1 * s1 + b1 * c1);
                    if (m < 3) { const f32x4 t0 = c0 * dc0 - s0 * ds0, t1 = c1 * dc1 - s1 * ds1; s0 = s0 * dc0 + c0 * ds0; s1 = s1 * dc1 + c1 * ds1; c0 = t0; c1 = t1; }
                }
            }
        } else {
#pragma unroll
            for (int ai = 0; ai < 2; ++ai)
#pragma unroll
                for (int m = 0; m < 4; ++m) { const float r1 = rsl[wr * 64 + fr + ai * HALF + m * 16]; bf16* op = pbase + (size_t)(row0 + ai * HALF + m * 16) * RV;
                    *(u32x4*)op = pack8(acc[ai][0][m][0] * r1, acc[ai][0][m][1] * r1);
                    *(u32x4*)(op + HALF) = pack8(acc[ai][1][m][0] * r1, acc[ai][1][m][1] * r1); }
        }
    }
};
struct EpiPoolIn {
    static constexpr bool PERM = true, BMAP = true;
    static constexpr bool NEED_RSTD = true;
    bf16* P; const float* rp;
    __device__ __forceinline__ void operator()(const f32x4 (&acc)[2][2][4][2], const Unit& u, int wr, int wc, int fr, int fq, const PG8_LAS float* rsl) const {
        const bool lo = fr < 8; const int rowI = u.pm * BM + wr * 64 + (fr & 7), colI = u.pn * BM + wc * 64 + 32 * (fr >> 3) + 8 * fq;
#pragma unroll
        for (int ai = 0; ai < 2; ++ai)
#pragma unroll
            for (int m = 0; m < 4; ++m) {
                const float rs = rsl[wr * 64 + fr + ai * HALF + m * 16];
                u32x4 i0, i1; xchg8(lo, pack8(acc[ai][0][m][0] * rs, acc[ai][0][m][1] * rs), pack8(acc[ai][1][m][0] * rs, acc[ai][1][m][1] * rs), i0, i1);
                bf16* op = P + (size_t)(rowI + ai * HALF + m * 16) * PINP + colI;
                *(u32x4*)op = i0; *(u32x4*)(op + 8 * PINP) = i1;
            }
    }
};
struct EpiResid {
    static constexpr bool PERM = true, BMAP = true;
    static constexpr bool NEED_RSTD = false;
    const bf16* hin; bf16* hout; bf16* hg; const float* gnext; float* rp;
    __device__ __forceinline__ void operator()(const f32x4 (&acc)[2][2][4][2], const Unit& u, int wr, int wc, int fr, int fq, const PG8_LAS float*) const {
        const bool lo = fr < 8; const int rowI = u.pm * BM + wr * 64 + (fr & 7), colI = u.pn * BM + wc * 64 + 32 * (fr >> 3) + 8 * fq, col0 = u.pn * BM + wc * 64 + 8 * fq;
        f32x4 g[2][2];
#pragma unroll
        for (int bj = 0; bj < 2; ++bj)
#pragma unroll
            for (int n = 0; n < 2; ++n) g[bj][n] = *(const f32x4*)(gnext + col0 + bj * 32 + 4 * n);
#pragma unroll
        for (int ai = 0; ai < 2; ++ai) {
            float ssm[4];
#pragma unroll
            for (int m = 0; m < 4; ++m) {
                const size_t off = (size_t)(rowI + ai * HALF + m * 16) * D + colI;
                u32x4 hv0, hv1; xchg8(lo, *(const u32x4*)(hin + off), *(const u32x4*)(hin + off + 8 * D), hv0, hv1);
                const f32x4 a0 = bf4lo(hv0.x, hv0.y) + acc[ai][0][m][0], a1 = bf4lo(hv0.z, hv0.w) + acc[ai][0][m][1], b0 = bf4lo(hv1.x, hv1.y) + acc[ai][1][m][0], b1 = bf4lo(hv1.z, hv1.w) + acc[ai][1][m][1];
                float ss = ((a0.x * a0.x + a0.y * a0.y) + (a0.z * a0.z + a0.w * a0.w)) + ((a1.x * a1.x + a1.y * a1.y) + (a1.z * a1.z + a1.w * a1.w))
                         + ((b0.x * b0.x + b0.y * b0.y) + (b0.z * b0.z + b0.w * b0.w)) + ((b1.x * b1.x + b1.y * b1.y) + (b1.z * b1.z + b1.w * b1.w));
                ss += __shfl_xor(ss, 16); ss += __shfl_xor(ss, 32); ssm[m] = ss;
                u32x4 i0, i1; xchg8(lo, pack8(a0, a1), pack8(b0, b1), i0, i1);
                *(u32x4*)(hout + off) = i0; *(u32x4*)(hout + off + 8 * D) = i1;
                xchg8(lo, pack8(a0 * g[0][0], a1 * g[0][1]), pack8(b0 * g[1][0], b1 * g[1][1]), i0, i1);
                *(u32x4*)(hg + off) = i0; *(u32x4*)(hg + off + 8 * D) = i1;
            }
            const float sv = fq == 0 ? ssm[0] : (fq == 1 ? ssm[1] : (fq == 2 ? ssm[2] : ssm[3]));
            rp[((size_t)(u.pm * 4 + 2 * ai + wr) * 32 + u.pn * 4 + wc) * 64 + fr + 16 * fq] = sv;
        }
    }
};
struct EpiPoolGate {
    static constexpr bool PERM = true, BMAP = true;
    static constexpr bool NEED_RSTD = false;
    const float* bias; const float* scale; bf16* P;
    __device__ __forceinline__ void operator()(const f32x4 (&acc)[2][2][4][2], const Unit& u, int wr, int wc, int fr, int fq, const PG8_LAS float*) const {
        const bool lo = fr < 8; const int rowI = u.pm * BM + wr * 64 + (fr & 7), colI = u.pn * BM + wc * 64 + 32 * (fr >> 3) + 8 * fq, col0 = u.pn * BM + wc * 64 + 8 * fq;
        f32x4 b[2][2], sc[2][2];
#pragma unroll
        for (int bj = 0; bj < 2; ++bj)
#pragma unroll
            for (int n = 0; n < 2; ++n) { b[bj][n] = *(const f32x4*)(bias + col0 + bj * 32 + 4 * n); sc[bj][n] = *(const f32x4*)(scale + col0 + bj * 32 + 4 * n); }
#pragma unroll
        for (int ai = 0; ai < 2; ++ai)
#pragma unroll
            for (int m = 0; m < 4; ++m) {
                bf16* op = P + (size_t)(rowI + ai * HALF + m * 16) * PINP + colI;
                u32x4 z0, z1; xchg8(lo, *(const u32x4*)(op + PW), *(const u32x4*)(op + PW + 8 * PINP), z0, z1);
                const f32x4 v00 = (acc[ai][0][m][0] + b[0][0]) * sc[0][0] * silu4(bf4lo(z0.x, z0.y)), v01 = (acc[ai][0][m][1] + b[0][1]) * sc[0][1] * silu4(bf4lo(z0.z, z0.w));
                const f32x4 v10 = (acc[ai][1][m][0] + b[1][0]) * sc[1][0] * silu4(bf4lo(z1.x, z1.y)), v11 = (acc[ai][1][m][1] + b[1][1]) * sc[1][1] * silu4(bf4lo(z1.z, z1.w));
                u32x4 i0, i1; xchg8(lo, pack8(v00, v01), pack8(v10, v11), i0, i1);
                *(u32x4*)op = i0; *(u32x4*)(op + 8 * PINP) = i1;
            }
    }
};

template <class Epi, class Sched, bool ALIGN_EPI>
__device__ __forceinline__ void gemm_phase(PG8_LAS unsigned char* lds, const Gemm g, const Sched& S, const Epi& E) {
    int tid_ = threadIdx.x; asm volatile("" : "+v"(tid_));
    const int tid = tid_, wid = __builtin_amdgcn_readfirstlane(tid >> 6), lane = tid & 63, wr = wid >> 2, wc = wid & 3, fr = lane & 15, fq = lane >> 4;
    const int K = g.K, nt = K / BK;
    unsigned voffA[2], voffB[2];
#pragma unroll
    for (int i = 0; i < 2; ++i) { int R, C; stage_rc(tid * 16 + i * 8192, R, C);
        const int Rb = Epi::BMAP ? (64 * (R >> 5) + perm32(R & 31)) : (Epi::PERM ? ((R & ~31) + perm32(R & 31)) : R);
        voffA[i] = (unsigned)(R * g.lda + C) * 2u; voffB[i] = (unsigned)(Rb * g.ldb + C) * 2u; }
    const size_t kstep = (size_t)(BK * 2);
    const size_t hsA = (size_t)HALF * g.lda * 2, hsB = (size_t)(Epi::BMAP ? 32 : HALF) * g.ldb * 2;
    const size_t tsA = 2 * hsA, tsB = (size_t)BM * g.ldb * 2;
    const unsigned ldsw = (unsigned)wid * 1024u;
    const int aoff = lds_byte(wr * 64 + fr, fq * 8), boff = lds_byte(wc * 32 + fr, fq * 8);
#define PG8_SA(b, h) (((b) * 2 + (h)) * HTB)
#define PG8_SB(b, h) ((4 + (b) * 2 + (h)) * HTB)
#define PG8_STAGE(bufoff, gbase, voff) do { _Pragma("unroll") for (int _i = 0; _i < 2; ++_i) \
        __builtin_amdgcn_global_load_lds((const unsigned*)((const char*)(gbase) + (voff)[_i]), (PG8_LAS unsigned*)(lds + (bufoff) + ldsw + _i * 8192), 16, 0, 0); } while (0)
#define PG8_LDA(dst, b, h) do { _Pragma("unroll") for (int m = 0; m < 4; ++m) _Pragma("unroll") for (int k = 0; k < 2; ++k) dst[m][k] = *(const PG8_LAS bf16x8*)(lds + PG8_SA(b, h) + aoff + m * 2048 + k * 1024); } while (0)
#define PG8_LDB(dst, b, h) do { _Pragma("unroll") for (int n = 0; n < 2; ++n) _Pragma("unroll") for (int k = 0; k < 2; ++k) dst[n][k] = *(const PG8_LAS bf16x8*)(lds + PG8_SB(b, h) + boff + n * 2048 + k * 1024); } while (0)
#define PG8_MMA(ai, bj, At, Bt) do { __builtin_amdgcn_s_setprio(1); _Pragma("unroll") for (int m = 0; m < 4; ++m) _Pragma("unroll") for (int n = 0; n < 2; ++n) _Pragma("unroll") for (int k = 0; k < 2; ++k) \
        acc[ai][bj][m][n] = __builtin_amdgcn_mfma_f32_16x16x32_bf16(Bt[n][k], At[m][k], acc[ai][bj][m][n], 0, 0, 0); __builtin_amdgcn_s_setprio(0); } while (0)
#define PG8_WAIT_V(n) asm volatile("s_waitcnt vmcnt(" #n ")" ::: "memory")
#define PG8_WAIT_L(n) asm volatile("s_waitcnt lgkmcnt(" #n ")" ::: "memory")
#define PG8_BAR __builtin_amdgcn_s_barrier()
#define PG8_SCHED __builtin_amdgcn_sched_barrier(0)
#define PG8_AKOFF(u) (g.grp_tiles ? (size_t)((u).pn / g.grp_tiles) * (size_t)g.grp_koff * 2 : (size_t)0)
    Unit cur, nxt; int ui = 0, rs_pm = -1;
    if (!S.next(0, cur)) return;
    f32x4 acc[2][2][4][2];
#pragma unroll
    for (int a = 0; a < 2; ++a)
#pragma unroll
        for (int b = 0; b < 2; ++b)
#pragma unroll
            for (int m = 0; m < 4; ++m)
#pragma unroll
                for (int n = 0; n < 2; ++n) acc[a][b][m][n] = (f32x4){0.f, 0.f, 0.f, 0.f};
    bf16x8 At[4][2], B0[2][2], B1[2][2];
    const char* cA = (const char*)g.A + (size_t)cur.pm * tsA + PG8_AKOFF(cur); const char* cB = (const char*)g.Bt + (size_t)cur.pn * tsB;
    PG8_STAGE(PG8_SB(0, 0), cB, voffB); PG8_STAGE(PG8_SB(0, 1), cB + hsB, voffB); PG8_STAGE(PG8_SA(0, 0), cA, voffA); PG8_STAGE(PG8_SA(0, 1), cA + hsA, voffA);
    if (wr == 1) PG8_BAR;
    PG8_WAIT_V(2); PG8_BAR;
    PG8_STAGE(PG8_SB(1, 0), cB + kstep, voffB); PG8_STAGE(PG8_SA(1, 0), cA + kstep, voffA); PG8_STAGE(PG8_SB(1, 1), cB + hsB + kstep, voffB);
    PG8_WAIT_V(6); PG8_BAR;
    for (;;) {
        const bool has_next = S.next(ui + 1, nxt);
        const char* nA = has_next ? (const char*)g.A + (size_t)nxt.pm * tsA + PG8_AKOFF(nxt) : cA; const char* nB = has_next ? (const char*)g.Bt + (size_t)nxt.pn * tsB : cB;
        for (int t = 0; t < nt; t += 2) {
            const bool last = (t == nt - 2);
            const char* a1 = cA + (size_t)(t + 1) * kstep;
            const char* a2 = last ? nA : cA + (size_t)(t + 2) * kstep; const char* b2 = last ? nB : cB + (size_t)(t + 2) * kstep;
            const char* a3 = a2 + kstep; const char* b3 = b2 + kstep;
            PG8_LDB(B0, 0, 0); PG8_LDB(B1, 0, 1); PG8_SCHED; PG8_LDA(At, 0, 0); PG8_STAGE(PG8_SA(1, 1), a1 + hsA, voffA);
            PG8_WAIT_V(8); PG8_WAIT_L(0); PG8_BAR; PG8_MMA(0, 0, At, B0); PG8_MMA(0, 1, At, B1); PG8_BAR; PG8_SCHED;
            PG8_LDA(At, 0, 1); PG8_STAGE(PG8_SB(0, 0), b2, voffB); PG8_STAGE(PG8_SB(0, 1), b2 + hsB, voffB); PG8_STAGE(PG8_SA(0, 0), a2, voffA);
            PG8_WAIT_V(8); PG8_WAIT_L(0); PG8_BAR; PG8_MMA(1, 0, At, B0); PG8_MMA(1, 1, At, B1); PG8_BAR; PG8_SCHED;
            PG8_LDB(B0, 1, 0); PG8_LDB(B1, 1, 1); PG8_SCHED; PG8_LDA(At, 1, 0); PG8_STAGE(PG8_SA(0, 1), a2 + hsA, voffA);
            PG8_WAIT_V(8); PG8_WAIT_L(0); PG8_BAR; PG8_MMA(0, 0, At, B0); PG8_MMA(0, 1, At, B1); PG8_BAR; PG8_SCHED;
            PG8_LDA(At, 1, 1); PG8_STAGE(PG8_SB(1, 0), b3, voffB); PG8_STAGE(PG8_SB(1, 1), b3 + hsB, voffB); PG8_STAGE(PG8_SA(1, 0), a3, voffA);
            PG8_WAIT_V(8); PG8_WAIT_L(0); PG8_BAR; PG8_MMA(1, 0, At, B0); PG8_MMA(1, 1, At, B1); PG8_BAR; PG8_SCHED;
        }
        if constexpr (ALIGN_EPI) { if (wr == 0) PG8_BAR; }
        const PG8_LAS float* rsl = (const PG8_LAS float*)(lds + STAGE_BYTES);
        if constexpr (Epi::NEED_RSTD) {
            static_assert(ALIGN_EPI, "the table's barrier needs both half-workgroups at the same point");
            if (cur.pm != rs_pm) {
                int t_ = threadIdx.x; asm volatile("" : "+v"(t_));
                const int prow = t_ >> 1; const float* p1 = E.rp + ((size_t)(cur.pm * 4 + (prow >> 6)) * 32 + 16 * (t_ & 1)) * 64 + (prow & 63);
                float pv[16];
#pragma unroll
                for (int k = 0; k < 16; ++k) pv[k] = p1[k * 64];
                float ssum = (((pv[0] + pv[1]) + (pv[2] + pv[3])) + ((pv[4] + pv[5]) + (pv[6] + pv[7]))) + (((pv[8] + pv[9]) + (pv[10] + pv[11])) + ((pv[12] + pv[13]) + (pv[14] + pv[15]))); ssum += __shfl_xor(ssum, 1);
                if (!(t_ & 1)) ((PG8_LAS float*)(lds + STAGE_BYTES))[t_ >> 1] = 1.0f / sqrtf(ssum * (1.0f / (float)D) + EPS);
                PG8_WAIT_L(0); PG8_BAR; asm volatile("" ::: "memory");
                rs_pm = cur.pm;
            }
        }
        { int fr_ = fr, fq_ = fq; asm volatile("" : "+v"(fr_), "+v"(fq_)); E(acc, cur, wr, wc, fr_, fq_, rsl); }
        if (!has_next) break;
#pragma unroll
        for (int a = 0; a < 2; ++a)
#pragma unroll
            for (int b = 0; b < 2; ++b)
#pragma unroll
                for (int m = 0; m < 4; ++m)
#pragma unroll
                    for (int n = 0; n < 2; ++n) acc[a][b][m][n] = (f32x4){0.f, 0.f, 0.f, 0.f};
        cur = nxt; cA = nA; cB = nB; ++ui;
        if constexpr (ALIGN_EPI) { if (wr == 1) PG8_BAR; }
    }
    PG8_WAIT_V(0);
    if constexpr (!ALIGN_EPI) { if (wr == 0) PG8_BAR; }
    PG8_BAR;
#undef PG8_SA
#undef PG8_SB
#undef PG8_STAGE
#undef PG8_LDA
#undef PG8_LDB
#undef PG8_MMA
#undef PG8_WAIT_V
#undef PG8_WAIT_L
#undef PG8_BAR
#undef PG8_SCHED
#undef PG8_AKOFF
}
}

typedef float f32x16 __attribute__((ext_vector_type(16)));
namespace ret {
constexpr int CH = 64, QS = 528, VS = 144;
constexpr int OFF_Q = 0, OFF_K = 32768, KBUF = 32768, OFF_S = 98304, OFF_P = 132096, OFF_VD = 141312, VBUF = 9216, LDS_END = 159744;
#define RET_BAR() do { asm volatile("s_waitcnt lgkmcnt(0)" ::: "memory"); __builtin_amdgcn_s_barrier(); asm volatile("" ::: "memory"); } while (0)
#define RET_MFMA(a, b, c) __builtin_amdgcn_mfma_f32_32x32x16_bf16((a), (b), (c), 0, 0, 0)
__device__ __forceinline__ bf16x8 cat8(u32x2 lo, u32x2 hi) { u32x4 v; v.x = lo.x; v.y = lo.y; v.z = hi.x; v.w = hi.y; return __builtin_bit_cast(bf16x8, v); }
__device__ __forceinline__ int swz(int R) { return ((R & 3) << 2) | ((R >> 2) & 3); }

__device__ __forceinline__ void retention_phase(LAS unsigned char* lds, bf16* P, bf16* Ob, int ldo, float* statp, int vcu, int G) {
    int tid_ = threadIdx.x; asm volatile("" : "+v"(tid_));
    const int tid = tid_, lane = tid & 63, wave = __builtin_amdgcn_readfirstlane(tid >> 6);
    const int r = lane & 31, hh = lane >> 5, blk = (lane >> 4) & 1, q = (lane & 15) >> 2, p = lane & 3;
    const unsigned ldsb = (unsigned)(size_t)lds;
    const int w4 = wave & 3, tb = w4 >> 1, ib = w4 & 1;
    const int fr4 = swz(r);
    const unsigned trK0 = (unsigned)((8 * hh + q) * 512 + (16 * (wave >> 2) + 4 * ((wave & 3) ^ q) + 2 * (blk ^ hh) + ((p >> 1) ^ 0)) * 16 + 8 * (p & 1));
    const unsigned trK1 = (unsigned)((8 * hh + 4 + q) * 512 + (16 * (wave >> 2) + 4 * ((wave & 3) ^ q) + 2 * (blk ^ hh) + ((p >> 1) ^ 1)) * 16 + 8 * (p & 1));
    const unsigned trV = (unsigned)((8 * hh + q) * VS + (16 * blk + 4 * p) * 2);
    unsigned dsrc[4];
#pragma unroll
    for (int k = 0; k < 4; ++k) { const int row = 2 * (4 * wave + k) + (lane >> 5); dsrc[k] = (unsigned)(row * (RV * 2) + (((lane & 31) ^ swz(row)) * 16)); }
#define RET_DMA(GSRC, LOFF) do { _Pragma("unroll") for (int k = 0; k < 4; ++k) \
        __builtin_amdgcn_global_load_lds((const unsigned*)((const char*)(GSRC) + dsrc[k]), (LAS unsigned*)(lds + (LOFF) + (4 * wave + k) * 1024), 16, 0, 0); } while (0)
    for (int u = vcu; u < BATCH * NH * 8; u += G) {
        const int es = u & 7, h = (u >> 3) & 7, b = u >> 6;
        const float lg2 = log2f(1.0f - exp2f(-5.0f - (float)h));
        const size_t rowbase = (size_t)b * SEQ;
        const bf16* gq = P + rowbase * RV + h * 256; const bf16* gk = gq + RQK; const bf16* gv = P + (size_t)M * RV + rowbase * RV + h * 512 + es * 64;
        const float cdecay = exp2f(64.0f * lg2);
        const float kd = exp2f((float)(CH - 1 - (tid >> 3)) * lg2);
        for (int i = tid; i < 33792 / 16; i += 512) *(LAS u32x4*)(lds + OFF_S + i * 16) = (u32x4){0u, 0u, 0u, 0u};
        f32x16 S0, S1;
#pragma unroll
        for (int i = 0; i < 16; ++i) { S0[i] = 0.f; S1[i] = 0.f; }
        const unsigned ov = (unsigned)((tid >> 3) * (RV * 2) + (tid & 7) * 16);
        u32x4 pv = *(const u32x4*)((const char*)gv + ov);
        RET_DMA(gq, OFF_Q); RET_DMA(gk, OFF_K);
        *(LAS u32x4*)(lds + OFF_VD + (tid >> 3) * VS + (tid & 7) * 16) = pg8::pack8(pg8::bf4lo(pv.x, pv.y) * kd, pg8::bf4lo(pv.z, pv.w) * kd);
#pragma unroll 1
        for (int c = 0; c < SEQ / CH; ++c) {
            const int t0 = c * CH; const unsigned vb = (unsigned)(c & 1) * VBUF, kb = (unsigned)(c & 1) * KBUF; const bool more = c + 1 < SEQ / CH;
            asm volatile("s_waitcnt vmcnt(0)" ::: "memory");
            RET_BAR();
            if (more) { RET_DMA(gk + (size_t)(t0 + CH) * RV, OFF_K + KBUF - kb); pv = *(const u32x4*)((const char*)(gv + (size_t)(t0 + CH) * RV) + ov); }
            f32x16 acc;
#pragma unroll
            for (int i = 0; i < 16; ++i) acc[i] = 0.f;
            if (wave < 4) {
                const LAS unsigned char* ap = lds + OFF_S + (32 * tb + r) * QS + 16 * hh; const LAS unsigned char* bp = lds + OFF_Q + (32 * ib + r) * 512;
#pragma unroll
                for (int ks = 0; ks < 16; ++ks) acc = RET_MFMA(*(const LAS bf16x8*)(ap + 32 * ks), *(const LAS bf16x8*)(bp + (((2 * ks + hh) ^ fr4) << 4)), acc);
            } else {
                if (!(tb == 1 && ib == 0)) {
                    const LAS unsigned char* ap = lds + OFF_K + kb + (32 * tb + r) * 512; const LAS unsigned char* bp = lds + OFF_Q + (32 * ib + r) * 512;
#pragma unroll
                    for (int ks = 0; ks < 16; ++ks) { const int co = ((2 * ks + hh) ^ fr4) << 4; acc = RET_MFMA(*(const LAS bf16x8*)(ap + co), *(const LAS bf16x8*)(bp + co), acc); }
                }
                int lo_ = lane; asm volatile("" : "+v"(lo_));
                const int rl = lo_ & 31, hl = lo_ >> 5, il = 32 * ib + rl;
                const float pf = exp2f((float)(il - (CH - 1)) * lg2);
#pragma unroll
                for (int g4 = 0; g4 < 4; ++g4) {
                    float pvv[4];
#pragma unroll
                    for (int e = 0; e < 4; ++e) { const int jl = 32 * tb + 8 * g4 + 4 * hl + e; pvv[e] = (il >= jl) ? acc[4 * g4 + e] * pf : 0.f; }
                    u32x2 w; w.x = pg8::cvt_pk_bf16(pvv[0], pvv[1]); w.y = pg8::cvt_pk_bf16(pvv[2], pvv[3]);
                    *(LAS u32x2*)(lds + OFF_P + il * VS + (32 * tb + 8 * g4 + 4 * hl) * 2) = w;
                }
            }
            RET_BAR();
            if (more) RET_DMA(gq + (size_t)(t0 + CH) * RV, OFF_Q);
            if (wave < 4) {
                const float qd = exp2f((float)(32 * ib + r + 1) * lg2);
#pragma unroll
                for (int i = 0; i < 16; ++i) acc[i] *= qd;
                const LAS unsigned char* bp = lds + OFF_P + (32 * ib + r) * VS + 16 * hh;
                {
                    u32x2 l0, h0, l1, h1, l2, h2, l3, h3; const unsigned a0 = ldsb + OFF_VD + vb + trV + 64 * tb;
                    asm volatile("ds_read_b64_tr_b16 %0, %8\n\tds_read_b64_tr_b16 %1, %8 offset:576\n\tds_read_b64_tr_b16 %2, %8 offset:2304\n\tds_read_b64_tr_b16 %3, %8 offset:2880\n\t"
                                 "ds_read_b64_tr_b16 %4, %8 offset:4608\n\tds_read_b64_tr_b16 %5, %8 offset:5184\n\tds_read_b64_tr_b16 %6, %8 offset:6912\n\tds_read_b64_tr_b16 %7, %8 offset:7488\n\ts_waitcnt lgkmcnt(0)"
                                 : "=&v"(l0), "=&v"(h0), "=&v"(l1), "=&v"(h1), "=&v"(l2), "=&v"(h2), "=&v"(l3), "=&v"(h3) : "v"(a0) : "memory");
                    __builtin_amdgcn_sched_barrier(0);
                    acc = RET_MFMA(cat8(l0, h0), *(const LAS bf16x8*)(bp), acc); acc = RET_MFMA(cat8(l1, h1), *(const LAS bf16x8*)(bp + 32), acc);
                    acc = RET_MFMA(cat8(l2, h2), *(const LAS bf16x8*)(bp + 64), acc); acc = RET_MFMA(cat8(l3, h3), *(const LAS bf16x8*)(bp + 96), acc);
                }
                const size_t row = rowbase + t0 + 32 * ib + r; bf16* op = Ob + row * (size_t)ldo + h * 512 + es * 64 + 32 * tb + 4 * hh;
                float sm = 0.f, sq = 0.f;
#pragma unroll
                for (int g4 = 0; g4 < 4; ++g4) {
                    u32x2 w; w.x = pg8::cvt_pk_bf16(acc[4 * g4], acc[4 * g4 + 1]); w.y = pg8::cvt_pk_bf16(acc[4 * g4 + 2], acc[4 * g4 + 3]);
                    *(u32x2*)(op + 8 * g4) = w;
#pragma unroll
                    for (int e = 0; e < 4; ++e) { const float v = acc[4 * g4 + e]; sm += v; sq += v * v; }
                }
                sm += __shfl_xor(sm, 32); sq += __shfl_xor(sq, 32);
                if (hh == 0) { float* sp = statp + ((row * NH + h) * 16 + 2 * es + tb) * 2; sp[0] = sm; sp[1] = sq; }
            }
#pragma unroll
            for (int i = 0; i < 16; ++i) { S0[i] *= cdecay; S1[i] *= cdecay; }
            {
                const unsigned ka0 = ldsb + OFF_K + kb + trK0, ka1 = ldsb + OFF_K + kb + trK1, va = ldsb + OFF_VD + vb + trV;
#define RET_G2(KOFF, VOFF) do { u32x2 al0, ah0, al1, ah1, p0, p1, p2, p3, p4, p5, p6, p7; \
                asm volatile("ds_read_b64_tr_b16 %0, %12 offset:" #KOFF "\n\tds_read_b64_tr_b16 %1, %13 offset:" #KOFF "\n\tds_read_b64_tr_b16 %2, %12 offset:" #KOFF "+8192\n\tds_read_b64_tr_b16 %3, %13 offset:" #KOFF "+8192\n\t" \
                             "ds_read_b64_tr_b16 %4, %14 offset:" #VOFF "\n\tds_read_b64_tr_b16 %5, %14 offset:" #VOFF "+576\n\tds_read_b64_tr_b16 %6, %14 offset:" #VOFF "+64\n\tds_read_b64_tr_b16 %7, %14 offset:" #VOFF "+640\n\t" \
                             "ds_read_b64_tr_b16 %8, %14 offset:" #VOFF "+2304\n\tds_read_b64_tr_b16 %9, %14 offset:" #VOFF "+2880\n\tds_read_b64_tr_b16 %10, %14 offset:" #VOFF "+2368\n\tds_read_b64_tr_b16 %11, %14 offset:" #VOFF "+2944\n\ts_waitcnt lgkmcnt(0)" \
                             : "=&v"(al0), "=&v"(ah0), "=&v"(al1), "=&v"(ah1), "=&v"(p0), "=&v"(p1), "=&v"(p2), "=&v"(p3), "=&v"(p4), "=&v"(p5), "=&v"(p6), "=&v"(p7) : "v"(ka0), "v"(ka1), "v"(va) : "memory"); \
                __builtin_amdgcn_sched_barrier(0); \
                { const bf16x8 a0 = cat8(al0, ah0), a1 = cat8(al1, ah1); \
                  S0 = RET_MFMA(a0, cat8(p0, p1), S0); S1 = RET_MFMA(a0, cat8(p2, p3), S1); S0 = RET_MFMA(a1, cat8(p4, p5), S0); S1 = RET_MFMA(a1, cat8(p6, p7), S1); } } while (0)
                RET_G2(0, 0); RET_G2(16384, 4608);
#undef RET_G2
            }
#pragma unroll
            for (int g4 = 0; g4 < 4; ++g4) {
                u32x2 w0, w1; w0.x = pg8::cvt_pk_bf16(S0[4 * g4], S0[4 * g4 + 1]); w0.y = pg8::cvt_pk_bf16(S0[4 * g4 + 2], S0[4 * g4 + 3]);
                w1.x = pg8::cvt_pk_bf16(S1[4 * g4], S1[4 * g4 + 1]); w1.y = pg8::cvt_pk_bf16(S1[4 * g4 + 2], S1[4 * g4 + 3]);
                *(LAS u32x2*)(lds + OFF_S + r * QS + (32 * wave + 8 * g4 + 4 * hh) * 2) = w0;
                *(LAS u32x2*)(lds + OFF_S + (32 + r) * QS + (32 * wave + 8 * g4 + 4 * hh) * 2) = w1;
            }
            if (more) *(LAS u32x4*)(lds + OFF_VD + (VBUF - vb) + (tid >> 3) * VS + (tid & 7) * 16) = pg8::pack8(pg8::bf4lo(pv.x, pv.y) * kd, pg8::bf4lo(pv.z, pv.w) * kd);
        }
        asm volatile("s_waitcnt vmcnt(0)" ::: "memory");
        RET_BAR();
    }
#undef RET_DMA
}
#undef RET_BAR
#undef RET_MFMA
}

constexpr int NWAVES = 8;
constexpr int RING_OFF = 0, RING_BYTES = 159744;
constexpr int LDSCTL_OFF = RING_BYTES, MISC_OFF = LDSCTL_OFF + 320;
constexpr int LDS_BYTES = 160768;
static_assert(ret::LDS_END <= RING_BYTES && pg8::STAGE_BYTES <= RING_BYTES, "LDS map");
constexpr int CW_BAR = 4096;
constexpr int N_PHASES = 18;

#define GAS __attribute__((address_space(1)))
typedef GAS unsigned gu32;
#define RLX_AGENT __ATOMIC_RELAXED, __HIP_MEMORY_SCOPE_AGENT

#define XB_TMO      128
#define XB_XCNT(j)  (256  + 64 * (j))
#define XB_XSUB(j)  (1280 + 64 * (j))
#define XB_XGEN(j)  (2304 + 64 * (j))
#define XB_TOP      3328
#define XB_TOPGEN   3392
#define XCD_BAR_WORDS 3456
#define XB_SPIN_CAP (1u << 18)

__device__ __forceinline__ unsigned xb_ld(unsigned* p)              { return __hip_atomic_load(p, __ATOMIC_RELAXED, __HIP_MEMORY_SCOPE_AGENT); }
__device__ __forceinline__ unsigned xb_add(unsigned* p, unsigned v) { return __hip_atomic_fetch_add(p, v, __ATOMIC_RELAXED, __HIP_MEMORY_SCOPE_AGENT); }
__device__ __forceinline__ unsigned xb_xcc_id() { return (unsigned)__builtin_amdgcn_s_getreg((3 << 11) | 20) & 0xFu; }
#define XB_SPIN(cond, bar) do { unsigned _sp = 0; while (cond) { __builtin_amdgcn_s_sleep(1); \
    if ((++_sp & 255u) == 0u) { if (xb_ld(&(bar)[XB_TMO])) break; if (_sp > XB_SPIN_CAP) { atomicAdd(&(bar)[XB_TMO], 1u); break; } } } } while (0)

struct XcdBarrier { unsigned* bar; unsigned x; volatile LAS unsigned* st; };
__device__ __forceinline__ XcdBarrier xcd_barrier_post(unsigned* bar, volatile LAS unsigned* st) {
    XcdBarrier b; b.bar = bar; b.x = xb_xcc_id(); b.st = st;
    if (threadIdx.x == 0) (void)xb_add(&bar[XB_XCNT(b.x)], 1u);
    return b;
}
__device__ __forceinline__ void xcd_barrier_complete(unsigned* bar, unsigned x, unsigned& nloc, unsigned& nx) {
    const unsigned G = gridDim.x * gridDim.y * gridDim.z;
    unsigned sum, cnt, mine, sp = 0u;
    for (;;) {
        sum = 0u; cnt = 0u; mine = 0u;
#pragma unroll
        for (unsigned j = 0; j < 16; ++j) { const unsigned c = xb_ld(&bar[XB_XCNT(j)]); sum += c; cnt += (c > 0u) ? 1u : 0u; mine = (j == x) ? c : mine; }
        if (sum == G) break;
        __builtin_amdgcn_s_sleep(1);
        if ((++sp & 255u) == 0u) { if (xb_ld(&bar[XB_TMO])) break; if (sp > XB_SPIN_CAP) { atomicAdd(&bar[XB_TMO], 1u); break; } }
    }
    nloc = mine > 0u ? mine : 1u; nx = cnt > 0u ? cnt : 1u;
}
__device__ __forceinline__ void xcd_barrier(const XcdBarrier& b) {
    asm volatile("s_waitcnt vmcnt(0)" ::: "memory");
    __syncthreads();
    if (threadIdx.x == 0) {
        unsigned* bar = b.bar;
        __builtin_amdgcn_s_waitcnt(0);
        unsigned nloc = b.st[0], nx = b.st[1];
        if (nloc == 0u) { xcd_barrier_complete(bar, b.x, nloc, nx); b.st[0] = nloc; b.st[1] = nx; }
        const unsigned old = xb_add(&bar[XB_XSUB(b.x)], 1u);
        const unsigned gen = old / nloc;
        if (old + 1u == (gen + 1u) * nloc) {
            __builtin_amdgcn_fence(__ATOMIC_RELEASE, "agent");
            asm volatile("s_waitcnt vmcnt(0)" ::: "memory");
            const unsigned og = xb_add(&bar[XB_TOP], 1u);
            const unsigned tg = og / nx;
            if (og + 1u == (tg + 1u) * nx) xb_add(&bar[XB_TOPGEN], 1u);
            else XB_SPIN(xb_ld(&bar[XB_TOPGEN]) == tg, bar);
            __builtin_amdgcn_fence(__ATOMIC_ACQUIRE, "agent");
            xb_add(&bar[XB_XGEN(b.x)], 1u);
            asm volatile("s_waitcnt vmcnt(0)" ::: "memory");
        } else {
            XB_SPIN(xb_ld(&bar[XB_XGEN(b.x)]) == gen, bar);
            __builtin_amdgcn_fence(__ATOMIC_ACQUIRE, "agent");
            asm volatile("s_waitcnt vmcnt(0)" ::: "memory");
        }
    }
    __syncthreads();
}

struct Args {
    const float *x, *ret_norm, *ret_w_in, *ret_gn, *ret_w_out, *pool_norm, *pool_w_in, *pool_w_grp, *pool_b_grp, *pool_scale, *pool_w_out, *final_norm;
    float* out; unsigned char* ws; int ph_lo, ph_hi, li, pad;
};

__device__ __forceinline__ void gate_phase(bf16* P, bf16* Ob, int ldo, const float* statp, const float* gn, int gw, int NGW, int lane) {
    for (int blk = gw; blk < (M / 8) * NH; blk += NGW) {
        const int h = blk & 7; const size_t row0 = (size_t)(blk >> 3) * 8;
        float st[8]; u32x4 ov[8], zv[8];
#pragma unroll
        for (int i = 0; i < 8; ++i) {
            st[i] = (lane < 32) ? statp[((row0 + i) * NH + h) * 32 + lane] : 0.f;
            const bf16* op = P + (size_t)M * RV + (row0 + i) * RV + h * 512 + lane * 8;
            ov[i] = *(const u32x4*)op; zv[i] = *(const u32x4*)(op + (size_t)M * RV);
        }
        const f32x4 g0 = *(const f32x4*)(gn + h * 512 + lane * 8), g1 = *(const f32x4*)(gn + h * 512 + lane * 8 + 4);
#pragma unroll
        for (int i = 0; i < 8; ++i) {
            float v = st[i];
#pragma unroll
            for (int o = 2; o < 32; o <<= 1) v += __shfl_xor(v, o);
            const float sm = __shfl(v, 0), sq = __shfl(v, 1);
            const float mu = sm * (1.0f / 512.f), var = fmaxf(sq * (1.0f / 512.f) - mu * mu, 0.f), rs = 1.0f / sqrtf(var + EPS);
            const f32x4 o0 = (pg8::bf4lo(ov[i].x, ov[i].y) - mu) * rs * g0 * pg8::silu4(pg8::bf4lo(zv[i].x, zv[i].y)), o1 = (pg8::bf4lo(ov[i].z, ov[i].w) - mu) * rs * g1 * pg8::silu4(pg8::bf4lo(zv[i].z, zv[i].w));
            *(u32x4*)(Ob + (row0 + i) * (size_t)ldo + h * 512 + lane * 8) = pg8::pack8(o0, o1);
        }
    }
}
template <int W> __device__ __forceinline__ void mix_block(const bf16* P, bf16* MIX, size_t row0, int t0, int c) {
    constexpr int NR = W - 1 + 16;
    u32x4 v[NR];
    const bf16* up = P + row0 * PINP + c;
    if (t0 == 0) {
#pragma unroll
        for (int k = 0; k < W - 1; ++k) v[k] = (u32x4){0u, 0u, 0u, 0u};
    } else {
#pragma unroll
        for (int k = 0; k < W - 1; ++k) v[k] = *(const u32x4*)(up - (size_t)(W - 1 - k) * PINP);
    }
#pragma unroll
    for (int k = 0; k < 16; ++k) v[W - 1 + k] = *(const u32x4*)(up + (size_t)k * PINP);
    f32x4 s0 = (f32x4){0.f, 0.f, 0.f, 0.f}, s1 = s0;
#pragma unroll
    for (int k = 0; k < W - 1; ++k) { s0 += pg8::bf4lo(v[k].x, v[k].y); s1 += pg8::bf4lo(v[k].z, v[k].w); }
#pragma unroll
    for (int r = 0; r < 16; ++r) {
        const f32x4 u0 = pg8::bf4lo(v[W - 1 + r].x, v[W - 1 + r].y), u1 = pg8::bf4lo(v[W - 1 + r].z, v[W - 1 + r].w);
        s0 += u0; s1 += u1;
        const int n = (t0 + r + 1 < W) ? t0 + r + 1 : W; const float inv = 1.0f / (float)n;
        *(u32x4*)(MIX + (row0 + r) * PW + c) = pg8::pack8(s0 * inv - u0, s1 * inv - u1);
        s0 -= pg8::bf4lo(v[r].x, v[r].y); s1 -= pg8::bf4lo(v[r].z, v[r].w);
    }
}
__device__ __forceinline__ void mix_phase(const bf16* P, bf16* MIX, int gw, int NGW, int lane) {
    for (int it = gw; it < (M / 16) * 8; it += NGW) {
        const int rb = it >> 3, c = ((it & 7) * 64 + lane) * 8, g = (it & 7) >> 1; const size_t row0 = (size_t)rb * 16; const int t0 = (int)(row0 & (SEQ - 1));
        if (g == 0) mix_block<2>(P, MIX, row0, t0, c); else if (g == 1) mix_block<4>(P, MIX, row0, t0, c); else if (g == 2) mix_block<8>(P, MIX, row0, t0, c); else mix_block<16>(P, MIX, row0, t0, c);
    }
}
__device__ __forceinline__ void final_phase(const bf16* h, float* o, const float* rp, const float* g, int gw, int NGW, int lane) {
    for (int row = 4 * gw; row < M; row += 4 * NGW) {
        u32x4 v[4][4]; float s[4];
#pragma unroll
        for (int i = 0; i < 4; ++i) { s[i] = (lane < 32) ? rp[((size_t)((row + i) >> 6) * 32 + lane) * 64 + ((row + i) & 63)] : 0.f;
#pragma unroll
            for (int j = 0; j < 4; ++j) v[i][j] = *((const u32x4*)(h + (size_t)(row + i) * D) + lane + 64 * j); }
        f32x4 gg[4][2];
#pragma unroll
        for (int j = 0; j < 4; ++j) { gg[j][0] = *((const f32x4*)g + 2 * (lane + 64 * j)); gg[j][1] = *((const f32x4*)g + 2 * (lane + 64 * j) + 1); }
#pragma unroll
        for (int i = 0; i < 4; ++i) { const float rs = 1.0f / sqrtf(wave_sum(s[i]) * (1.0f / (float)D) + EPS);
#pragma unroll
            for (int j = 0; j < 4; ++j) { f32x4* op = (f32x4*)(o + (size_t)(row + i) * D) + 2 * (lane + 64 * j);
                op[0] = pg8::bf4lo(v[i][j].x, v[i][j].y) * rs * gg[j][0]; op[1] = pg8::bf4lo(v[i][j].z, v[i][j].w) * rs * gg[j][1]; } }
    }
}
struct WSeg { const float* src; bf16* dst; int K, N, nmat; };
__device__ __forceinline__ void prologue_phase(const __attribute__((address_space(4))) Args* ka, LAS unsigned char* lds, int gw, int NGW, int wave, int lane) {
    const __attribute__((address_space(4))) Args* ap = ka; asm volatile("" : "+s"(ap));
    LAS float* scr = (LAS float*)(lds + RING_OFF + wave * 16384);
    unsigned char* ws = ap->ws;
#pragma unroll 1
    for (int s = 0; s < 5; ++s) {
        WSeg sg;
        if (s == 0) sg = WSeg{ap->ret_w_in, (bf16*)(ws + WS_W_RIN), D, RIN, 2};
        else if (s == 1) sg = WSeg{ap->ret_w_out, (bf16*)(ws + WS_W_ROUT), RV, D, 2};
        else if (s == 2) sg = WSeg{ap->pool_w_in, (bf16*)(ws + WS_W_PIN), D, PIN, 2};
        else if (s == 3) sg = WSeg{ap->pool_w_grp, (bf16*)(ws + WS_W_PGRP), PGD, PGD, 8};
        else sg = WSeg{ap->pool_w_out, (bf16*)(ws + WS_W_POUT), PW, D, 2};
        const int ipm = (sg.K / 64) * (sg.N / 32), total = ipm * sg.nmat;
        for (int it = gw; it < total; it += NGW) { const int mi = it / ipm, r = it % ipm;
            transpose_item(sg.src + (size_t)mi * sg.K * sg.N, sg.K, sg.N, sg.dst + (size_t)mi * sg.K * sg.N, scr, r, lane); }
    }
    bf16* hb = (bf16*)(ws + WS_HB); bf16* hgp = (bf16*)ap->out + (size_t)M * D; float* rp0 = (float*)(ws + WS_RP);
    for (int m = 2 * gw; m < M; m += 2 * NGW) {
        const f32x4* gr = (const f32x4*)ap->ret_norm + lane; f32x4 v[2][8];
#pragma unroll
        for (int i = 0; i < 2; ++i)
#pragma unroll
            for (int j = 0; j < 8; ++j) v[i][j] = *((const f32x4*)(ap->x + (size_t)(m + i) * D) + lane + 64 * j);
#pragma unroll
        for (int i = 0; i < 2; ++i) { float s = 0.f; u32x2* o8 = (u32x2*)(hb + (size_t)(m + i) * D) + lane; u32x2* g8 = (u32x2*)(hgp + (size_t)(m + i) * D) + lane;
#pragma unroll
            for (int j = 0; j < 8; ++j) { const f32x4 x4 = v[i][j], g = gr[64 * j]; s += (x4.x * x4.x + x4.y * x4.y) + (x4.z * x4.z + x4.w * x4.w);
                u32x2 w; w.x = pg8::cvt_pk_bf16(x4.x, x4.y); w.y = pg8::cvt_pk_bf16(x4.z, x4.w); o8[64 * j] = w;
                w.x = pg8::cvt_pk_bf16(x4.x * g.x, x4.y * g.y); w.y = pg8::cvt_pk_bf16(x4.z * g.z, x4.w * g.w); g8[64 * j] = w; }
            s = wave_sum(s);
            if (lane < 32) rp0[((size_t)((m + i) >> 6) * 32 + lane) * 64 + ((m + i) & 63)] = lane == 0 ? s : 0.f; }
    }
    float* cosT = (float*)(ws + WS_COS); float* sinT = (float*)(ws + WS_SIN);
    for (int i = gw * 64 + lane; i < SEQ * 128; i += NGW * 64) { const int s = i >> 7, dd = i & 127;
        const float inv = powf(10000.0f, -(float)dd / 128.0f); const float ang = (float)s * inv; cosT[i] = cosf(ang); sinT[i] = sinf(ang); }
    if (gw == 0) { float* stepT = (float*)(ws + WS_STEP);
        for (int dd = lane; dd < 128; dd += 64) { const float ang = 16.0f * powf(10000.0f, -(float)dd / 128.0f); stepT[dd] = cosf(ang); stepT[128 + dd] = sinf(ang); } }
}

#define KA_T const __attribute__((address_space(4))) Args
#define SITE_ARGS(a) KA_T* a = ka0; asm volatile("" : "+s"(a))
__global__ void __launch_bounds__(NWAVES * 64, 2) mega(Args args_unused) {
    extern __shared__ __attribute__((aligned(16))) unsigned char lds_raw[];
    LAS unsigned char* lds = (LAS unsigned char*)lds_raw;
    KA_T* ka0 = (KA_T*)__builtin_amdgcn_kernarg_segment_ptr();
    const int wave = __builtin_amdgcn_readfirstlane((int)threadIdx.x >> 6);
    const int G = gridDim.x, gw = blockIdx.x * NWAVES + wave, NGW = G * NWAVES;
    const int vcu = (G % 8 == 0) ? (int)(blockIdx.x % 8) * (G / 8) + (int)(blockIdx.x / 8) : (int)blockIdx.x;
    for (int u = threadIdx.x; u < (LDS_BYTES - LDSCTL_OFF) / 4; u += NWAVES * 64) ((LAS unsigned*)(lds + LDSCTL_OFF))[u] = 0u;
    __syncthreads();
    unsigned phmask; XcdBarrier bar;
    { SITE_ARGS(a); const int lo = a->ph_lo, hi = a->ph_hi;
      phmask = __builtin_amdgcn_readfirstlane((unsigned)(((1ull << hi) - 1ull) & ~((1ull << lo) - 1ull)));
      unsigned* bw = (unsigned*)(a->ws + WS_CTL) + CW_BAR + a->li * XCD_BAR_WORDS;
      bar.bar = bw; bar.x = 0; bar.st = nullptr;
      if (hi - lo > 1) bar = xcd_barrier_post(bw, (volatile LAS unsigned*)(lds + MISC_OFF) + 8); }
#define IN(k) ((phmask >> (k)) & 1u)
#define SEAM(k) do { if ((phmask >> (k)) & (phmask >> ((k) + 1)) & 1u) xcd_barrier(bar); } while (0)
#define LANE() ({ int t_ = threadIdx.x; asm volatile("" : "+v"(t_)); t_ & 63; })

    if (IN(0)) { prologue_phase(ka0, lds, gw, NGW, wave, LANE()); SEAM(0); }

#pragma unroll 1
    for (int lp = 0; lp < 2; ++lp) {
        const int pb = 1 + 8 * lp;
        if (IN(pb + 0)) {
            SITE_ARGS(a); unsigned char* ws = a->ws;
            pg8::Gemm g{(const bf16*)a->out + (size_t)M * D, (const bf16*)(ws + WS_W_RIN) + (size_t)lp * D * RIN, M, RIN, D, D, D, 0, 0}; pg8::StaticOrder S; S.init(M, RIN, G, (int)blockIdx.x);
            pg8::EpiRetIn E{ws, (const float*)(ws + WS_RP + (size_t)(2 * lp) * RP_STRIDE)};
            pg8::gemm_phase<pg8::EpiRetIn, pg8::StaticOrder, true>(lds + RING_OFF, g, S, E);

            SEAM(pb + 0);
        }
        if (IN(pb + 1)) { SITE_ARGS(a); unsigned char* ws = a->ws; ret::retention_phase(lds + RING_OFF, (bf16*)(ws + WS_P), (bf16*)(ws + WS_P) + (size_t)M * RV, RV, (float*)(ws + WS_ST), vcu, G); SEAM(pb + 1); }
        if (IN(pb + 2)) { SITE_ARGS(a); unsigned char* ws = a->ws; gate_phase((bf16*)(ws + WS_P), (bf16*)(ws + WS_P) + (size_t)M * RV, RV, (const float*)(ws + WS_ST), a->ret_gn + (size_t)lp * RV, gw, NGW, LANE()); SEAM(pb + 2); }
        if (IN(pb + 3)) {
            SITE_ARGS(a); unsigned char* ws = a->ws;
            pg8::Gemm g{(const bf16*)(ws + WS_P) + (size_t)M * RV, (const bf16*)(ws + WS_W_ROUT) + (size_t)lp * RV * D, M, D, RV, RV, RV, 0, 0}; pg8::StaticOrder S; S.init(M, D, G, (int)blockIdx.x);
            pg8::EpiResid E{(const bf16*)(ws + WS_HB), (bf16*)(ws + WS_HB), (bf16*)a->out + (size_t)M * D, a->pool_norm + (size_t)lp * D, (float*)(ws + WS_RP + (size_t)(2 * lp + 1) * RP_STRIDE)};
            pg8::gemm_phase<pg8::EpiResid, pg8::StaticOrder, true>(lds + RING_OFF, g, S, E);

            SEAM(pb + 3);
        }
        if (IN(pb + 4)) {
            SITE_ARGS(a); unsigned char* ws = a->ws;
            pg8::Gemm g{(const bf16*)a->out + (size_t)M * D, (const bf16*)(ws + WS_W_PIN) + (size_t)lp * D * PIN, M, PIN, D, D, D, 0, 0}; pg8::StaticOrder S; S.init(M, PIN, G, (int)blockIdx.x);
            pg8::EpiPoolIn E{(bf16*)(ws + WS_P), (const float*)(ws + WS_RP + (size_t)(2 * lp + 1) * RP_STRIDE)};
            pg8::gemm_phase<pg8::EpiPoolIn, pg8::StaticOrder, true>(lds + RING_OFF, g, S, E);

            SEAM(pb + 4);
        }
        if (IN(pb + 5)) { SITE_ARGS(a); unsigned char* ws = a->ws; mix_phase((const bf16*)(ws + WS_P), (bf16*)(ws + WS_MIX), gw, NGW, LANE()); SEAM(pb + 5); }
        if (IN(pb + 6)) {
            SITE_ARGS(a); unsigned char* ws = a->ws;
            pg8::Gemm g{(const bf16*)(ws + WS_MIX), (const bf16*)(ws + WS_W_PGRP) + (size_t)lp * PG * PGD * PGD, M, PW, PGD, PW, PGD, PGD / 256, PGD}; pg8::StaticOrder S; S.init(M, PW, G, (int)blockIdx.x);
            pg8::EpiPoolGate E{a->pool_b_grp + (size_t)lp * PW, a->pool_scale + (size_t)lp * PW, (bf16*)(ws + WS_P)};
            pg8::gemm_phase<pg8::EpiPoolGate, pg8::StaticOrder, true>(lds + RING_OFF, g, S, E);

            SEAM(pb + 6);
        }
        if (IN(pb + 7)) {
            SITE_ARGS(a); unsigned char* ws = a->ws;
            pg8::Gemm g{(const bf16*)(ws + WS_P), (const bf16*)(ws + WS_W_POUT) + (size_t)lp * PW * D, M, D, PW, PINP, PW, 0, 0}; pg8::StaticOrder S; S.init(M, D, G, (int)blockIdx.x);
            pg8::EpiResid E{(const bf16*)(ws + WS_HB), (bf16*)(ws + WS_HB), (bf16*)a->out + (size_t)M * D, lp == 0 ? a->ret_norm + D : a->final_norm, (float*)(ws + WS_RP + (size_t)(2 * lp + 2) * RP_STRIDE)};
            pg8::gemm_phase<pg8::EpiResid, pg8::StaticOrder, true>(lds + RING_OFF, g, S, E);

            SEAM(pb + 7);
        }
    }
    if (IN(17)) { SITE_ARGS(a); final_phase((const bf16*)(a->ws + WS_HB), a->out, (const float*)(a->ws + WS_RP + 4 * RP_STRIDE), a->final_norm, gw, NGW, LANE()); }
#undef IN
#undef SEAM
}

extern "C" void kernel_launch(void* const* d_in, const int* in_sizes, int n_in, void* d_out, int out_size, void* d_ws, size_t ws_size, hipStream_t stream) {
    static int grid = 0;
    if (grid == 0) {
        if (n_in != 12 || out_size != M * D || ws_size < WS_END) { fprintf(stderr, "kernel_launch: unexpected shapes / workspace (%d inputs, out %d, ws %zu)\n", n_in, out_size, ws_size); grid = -1; return; }
        int dev = 0, cus = 0, per_cu = 0;
        if (hipGetDevice(&dev) != hipSuccess || hipDeviceGetAttribute(&cus, hipDeviceAttributeMultiprocessorCount, dev) != hipSuccess) { grid = -1; return; }
        if (hipFuncSetAttribute((const void*)mega, hipFuncAttributeMaxDynamicSharedMemorySize, LDS_BYTES) != hipSuccess) { fprintf(stderr, "kernel_launch: hipFuncSetAttribute failed\n"); grid = -1; return; }
        if (hipOccupancyMaxActiveBlocksPerMultiprocessor(&per_cu, (const void*)mega, NWAVES * 64, LDS_BYTES) != hipSuccess || per_cu < 1) {
            fprintf(stderr, "kernel_launch: the occupancy query reports %d workgroups per CU for the persistent kernel; nothing launched\n", per_cu); (void)hipGetLastError(); grid = -1; return; }
        grid = cus;
    }
    if (grid < 0) return;
    (void)hipMemsetAsync((unsigned char*)d_ws + WS_CTL, 0, 32768, stream);
    Args a{};
    a.x = (const float*)d_in[0]; a.ret_norm = (const float*)d_in[1]; a.ret_w_in = (const float*)d_in[2]; a.ret_gn = (const float*)d_in[3]; a.ret_w_out = (const float*)d_in[4];
    a.pool_norm = (const float*)d_in[5]; a.pool_w_in = (const float*)d_in[6]; a.pool_w_grp = (const float*)d_in[7]; a.pool_b_grp = (const float*)d_in[8]; a.pool_scale = (const float*)d_in[9];
    a.pool_w_out = (const float*)d_in[10]; a.final_norm = (const float*)d_in[11]; a.out = (float*)d_out; a.ws = (unsigned char*)d_ws;
    a.ph_lo = 0; a.ph_hi = N_PHASES; a.li = 0; a.pad = 0;
    hipLaunchKernelGGL(mega, dim3(grid), dim3(NWAVES * 64), LDS_BYTES, stream, a);
}
```

```cpp
#include <hip/hip_runtime.h>
#include <stdint.h>
#include <stdio.h>

typedef unsigned short bf16;
typedef short bf16x8 __attribute__((ext_vector_type(8)));
typedef float f32x4 __attribute__((ext_vector_type(4)));
typedef unsigned u32x4 __attribute__((ext_vector_type(4)));
typedef unsigned u32x2 __attribute__((ext_vector_type(2)));
#define LAS __attribute__((address_space(3)))

constexpr int BATCH = 4, SEQ = 4096, D = 2048, M = BATCH * SEQ;
constexpr int NH = 8, HQK = 256, HV = 512, RQK = 2048, RV = 4096, RIN = 12288;
constexpr int PW = 4096, PG = 4, PGD = 1024, PIN = 8192;
constexpr int PINP = PW + 128;
constexpr float EPS = 1e-6f;

constexpr size_t MiB = (size_t)1 << 20;
constexpr size_t WS_CTL = 0, CTL_BYTES = 1 * MiB;
constexpr size_t WS_COS = 1 * MiB, WS_SIN = 3 * MiB;
constexpr size_t WS_RP = 5 * MiB;
constexpr size_t RP_STRIDE = 2 * MiB;
constexpr size_t WS_W_RIN = 16 * MiB, WS_W_ROUT = 112 * MiB, WS_W_PIN = 144 * MiB, WS_W_PGRP = 208 * MiB, WS_W_POUT = 224 * MiB;
constexpr size_t WS_HB = 256 * MiB;
constexpr size_t WS_P = 320 * MiB;
constexpr size_t WS_ZB = WS_P + (size_t)M * PINP * 2;
constexpr size_t WS_MIX = 584 * MiB;
constexpr size_t WS_ST = 720 * MiB;
constexpr size_t WS_END = 768 * MiB;

__device__ __forceinline__ unsigned f2bf(float f) { unsigned u = __builtin_bit_cast(unsigned, f); return (u + 0x7fffu + ((u >> 16) & 1u)) >> 16; }
__device__ __forceinline__ unsigned pk2(float lo, float hi) { return f2bf(lo) | (f2bf(hi) << 16); }
__device__ __forceinline__ float bf2f(unsigned b) { return __builtin_bit_cast(float, b << 16); }
__device__ __forceinline__ float silu(float z) { return z / (1.0f + __expf(-z)); }
__device__ __forceinline__ float wave_sum(float v) {
#pragma unroll
    for (int o = 1; o < 64; o <<= 1) v += __shfl_xor(v, o);
    return v;
}

__device__ __forceinline__ void transpose_item(const float* W, int K, int N, bf16* WT, LAS float* scr, int item, int lane, const float* gk = nullptr, bool bmap = true) {
    const int nblk = N / 32, kb = item / nblk, nb = item % nblk, k0 = 64 * kb, n0 = 32 * nb;
    f32x4 wv[8];
#pragma unroll
    for (int i = 0; i < 8; ++i) wv[i] = *(const f32x4*)(W + (size_t)(k0 + 8 * i + (lane >> 3)) * N + n0 + 4 * (lane & 7));
#pragma unroll
    for (int i = 0; i < 8; ++i) { const float gs = gk ? gk[k0 + 8 * i + (lane >> 3)] : 1.0f; LAS float* d = scr + (8 * i + (lane >> 3)) * 33 + 4 * (lane & 7); d[0] = wv[i].x * gs; d[1] = wv[i].y * gs; d[2] = wv[i].z * gs; d[3] = wv[i].w * gs; }
    asm volatile("s_waitcnt lgkmcnt(0)" ::: "memory");
    const int c = lane & 7;
#pragma unroll
    for (int j = 0; j < 4; ++j) { const int n = (lane >> 3) + 8 * j; const LAS float* s = scr + (8 * c) * 33 + n;
        u32x4 o; o.x = pk2(s[0 * 33], s[1 * 33]); o.y = pk2(s[2 * 33], s[3 * 33]); o.z = pk2(s[4 * 33], s[5 * 33]); o.w = pk2(s[6 * 33], s[7 * 33]);
        const int w = n0 + n, pn = w >> 8, wt = w & 255, rho = 16 * ((n >> 2) & 1) + 4 * (n >> 3) + (n & 3);
        const int h = bmap ? ((wt >> 5) & 1) : (wt >> 7), R = 32 * (bmap ? (wt >> 6) : ((wt & 127) >> 5)) + rho, k = k0 + 8 * c;
        const int ob = (R & 15) * 64 + ((k & 31) >> 3) * 16, pos = ob ^ (((ob >> 9) & 1) << 5);
        *(u32x4*)((char*)WT + ((size_t)((pn * 2 + h) * 8 + (R >> 4)) * (K >> 5) + (k >> 5)) * 1024 + pos) = o; }
    asm volatile("s_waitcnt lgkmcnt(0)" ::: "memory");
}

namespace pg8 {
#define PG8_LAS __attribute__((address_space(3)))
constexpr int BM = 256, BK = 64, HALF = 128, HTB = HALF * BK * 2  , STAGE_BYTES = 8 * HTB, NXCD = 8, WGM = 8;
__host__ __device__ __forceinline__ int lds_byte(int r, int c) { const int st = (r >> 4) * 2 + (c >> 5), rr = r & 15, cc = c & 31, ob = rr * 64 + cc * 2; return st * 1024 + (ob ^ (((ob >> 9) & 1) << 5)); }
__host__ __device__ __forceinline__ void stage_rc(int b, int& R, int& C) { const int st = b / 1024, sb = b % 1024, swz = sb ^ (((sb >> 9) & 1) << 5); R = (st >> 1) * 16 + swz / 64; C = (st & 1) * 32 + (swz % 64) / 2; }
__host__ __device__ __forceinline__ int perm32(int rho) { const int n = rho >> 4, i = rho & 15; return 8 * (i >> 2) + 4 * n + (i & 3); }

struct Unit { int pm, pn; };
struct Gemm { const bf16* A; const bf16* Bt; int M, N, K, lda, ldb, grp_tiles, grp_koff; };

struct StaticOrder {
    int nM, nN, nwg, G, c;
    __host__ __device__ void init(int M, int N, int G_, int c_) { nM = M / BM; nN = N / BM; nwg = nM * nN; G = G_; c = c_; }
    __host__ __device__ bool next(int i, Unit& u) const {
        const long L = (long)i * G + c; if (L >= nwg) return false;
        int wgid = (int)L; { const int q = nwg / NXCD, r = nwg % NXCD, xcd = wgid % NXCD, off = wgid / NXCD; wgid = (xcd < r ? xcd * (q + 1) : r * (q + 1) + (xcd - r) * q) + off; }
        const int nig = WGM * nN, gid = wgid / nig, fm = gid * WGM, gsz = (nM - fm) < WGM ? (nM - fm) : WGM;
        u.pm = fm + ((wgid % nig) % gsz); u.pn = (wgid % nig) / gsz; return true;
    }
};

typedef float f32x2 __attribute__((ext_vector_type(2)));
typedef __bf16 bf16x2_t __attribute__((ext_vector_type(2)));
__device__ __forceinline__ unsigned cvt_pk_bf16(float lo, float hi) { const f32x2 v = {lo, hi}; return __builtin_bit_cast(unsigned, __builtin_convertvector(v, bf16x2_t)); }
__device__ __forceinline__ u32x4 pack8(const f32x4 v0, const f32x4 v1) { u32x4 w; w.x = cvt_pk_bf16(v0[0], v0[1]); w.y = cvt_pk_bf16(v0[2], v0[3]); w.z = cvt_pk_bf16(v1[0], v1[1]); w.w = cvt_pk_bf16(v1[2], v1[3]); return w; }
__device__ __forceinline__ float row_rstd(const float* rp, int row, int fq) {
    const f32x4* p = (const f32x4*)(rp + (size_t)row * 32 + 8 * fq); const f32x4 a = p[0], b = p[1];
    float s = ((a.x + a.y) + (a.z + a.w)) + ((b.x + b.y) + (b.z + b.w));
    s += __shfl_xor(s, 16); s += __shfl_xor(s, 32);
    return 1.0f / sqrtf(s * (1.0f / (float)D) + EPS);
}
__device__ __forceinline__ u32x4 ror8(const u32x4 v) { u32x4 r;
#pragma unroll
    for (int j = 0; j < 4; ++j) r[j] = (unsigned)__builtin_amdgcn_update_dpp(0, (int)v[j], 0x128, 0xf, 0xf, false);
    return r; }
__device__ __forceinline__ void xchg8(bool lo, const u32x4 a, const u32x4 b, u32x4& o0, u32x4& o1) { const u32x4 y = ror8(lo ? b : a); o0 = lo ? a : y; o1 = lo ? y : b; }
__device__ __forceinline__ f32x4 silu4(const f32x4 z) { f32x4 r;
#pragma unroll
    for (int j = 0; j < 4; ++j) r[j] = z[j] * __builtin_amdgcn_rcpf(1.0f + __expf(-z[j]));
    return r; }
__device__ __forceinline__ f32x4 bf4lo(unsigned a, unsigned b) { return (f32x4){bf2f(a & 0xffffu), bf2f(a >> 16), bf2f(b & 0xffffu), bf2f(b >> 16)}; }

struct EpiRetIn {
    static constexpr bool PERM = true, BMAP = false;
    static constexpr bool NEED_RSTD = true;
    unsigned char* ws; const float* rp;
    __device__ __forceinline__ void operator()(const f32x4 (&acc)[2][2][4][2], const Unit& u, int wr, int wc, int fr, int fq, const PG8_LAS float* rsl) const {
        const int row0 = u.pm * BM + wr * 64 + fr, colw = wc * 32 + 8 * fq;
        const int kind = u.pn < 8 ? 0 : (u.pn < 16 ? 1 : 2);
        bf16* pbase = (bf16*)(ws + WS_P) + (size_t)(u.pn >> 4) * ((size_t)M * RV) + (u.pn & 15) * BM + colw;
        const float* cosT = (const float*)(ws + WS_COS); const float* sinT = (const float*)(ws + WS_SIN); const float* stepC = cosT + 16 * 128; const float* stepS = sinT + 16 * 128;
        if (kind < 2) {
            const float ks = kind == 1 ? 0.0625f : 1.0f;
            f32x4 c[2][2], s[2][2];
#pragma unroll
            for (int ai = 0; ai < 2; ++ai) { const int sp = (row0 + ai * HALF) & (SEQ - 1);
                const f32x4* cp = (const f32x4*)(cosT + sp * 128 + colw); const f32x4* sq = (const f32x4*)(sinT + sp * 128 + colw);
                c[ai][0] = cp[0]; c[ai][1] = cp[1]; s[ai][0] = sq[0]; s[ai][1] = sq[1]; }
            const f32x4 dc0 = *(const f32x4*)(stepC + colw), dc1 = *(const f32x4*)(stepC + colw + 4), ds0 = *(const f32x4*)(stepS + colw), ds1 = *(const f32x4*)(stepS + colw + 4);
#pragma unroll
            for (int ai = 0; ai < 2; ++ai) {
                f32x4 c0 = c[ai][0], c1 = c[ai][1], s0 = s[ai][0], s1 = s[ai][1];
#pragma unroll
                for (int m = 0; m < 4; ++m) {
                    const float r1 = rsl[wr * 64 + fr + ai * HALF + m * 16] * ks; bf16* op = pbase + (size_t)(row0 + ai * HALF + m * 16) * RV;
                    const f32x4 a0 = acc[ai][0][m][0] * r1, a1 = acc[ai][0][m][1] * r1, b0 = acc[ai][1][m][0] * r1, b1 = acc[ai][1][m][1] * r1;
                    *(u32x4*)op = pack8(a0 * c0 - b0 * s0, a1 * c1 - b1 * s1);
                    *(u32x4*)(op + HALF) = pack8(a0 * s0 + b0 * c0, a1 * s1 + b1 * c1);
                    if (m < 3) { const f32x4 t0 = c0 * dc0 - s0 * ds0, t1 = c1 * dc1 - s1 * ds1; s0 = s0 * dc0 + c0 * ds0; s1 = s1 * dc1 + c1 * ds1; c0 = t0; c1 = t1; }
                }
            }
        } else {
#pragma unroll
            for (int ai = 0; ai < 2; ++ai)
#pragma unroll
                for (int m = 0; m < 4; ++m) { const float r1 = rsl[wr * 64 + fr + ai * HALF + m * 16]; bf16* op = pbase + (size_t)(row0 + ai * HALF + m * 16) * RV;
                    *(u32x4*)op = pack8(acc[ai][0][m][0] * r1, acc[ai][0][m][1] * r1);
                    *(u32x4*)(op + HALF) = pack8(acc[ai][1][m][0] * r1, acc[ai][1][m][1] * r1); }
        }
    }
};
struct EpiPoolIn {
    static constexpr bool PERM = true, BMAP = true;
    static constexpr bool NEED_RSTD = true;
    bf16* P; bf16* ZB; const float* rp;
    __device__ __forceinline__ void operator()(const f32x4 (&acc)[2][2][4][2], const Unit& u, int wr, int wc, int fr, int fq, const PG8_LAS float* rsl) const {
        const bool lo = fr < 8; const int rowI = u.pm * BM + wr * 64 + (fr & 7), colI = u.pn * BM + wc * 64 + 32 * (fr >> 3) + 8 * fq;
        if (u.pn >= PW / BM) {
            bf16* zp = ZB + ((size_t)((u.pm * (PW / BM) + (u.pn - PW / BM)) * 8 + wr * 4 + wc) * 16) * 512 + (fq * 16 + fr) * 8;
#pragma unroll
            for (int ai = 0; ai < 2; ++ai)
#pragma unroll
                for (int m = 0; m < 4; ++m) {
                    const float rs = rsl[wr * 64 + fr + ai * HALF + m * 16];
                    *(u32x4*)(zp + ((ai * 4 + m) * 2 + 0) * 512) = pack8(acc[ai][0][m][0] * rs, acc[ai][0][m][1] * rs);
                    *(u32x4*)(zp + ((ai * 4 + m) * 2 + 1) * 512) = pack8(acc[ai][1][m][0] * rs, acc[ai][1][m][1] * rs);
                }
            return;
        }
#pragma unroll
        for (int ai = 0; ai < 2; ++ai)
#pragma unroll
            for (int m = 0; m < 4; ++m) {
                const float rs = rsl[wr * 64 + fr + ai * HALF + m * 16];
                u32x4 i0, i1; xchg8(lo, pack8(acc[ai][0][m][0] * rs, acc[ai][0][m][1] * rs), pack8(acc[ai][1][m][0] * rs, acc[ai][1][m][1] * rs), i0, i1);
                bf16* op = P + (size_t)(rowI + ai * HALF + m * 16) * PINP + colI;
                *(u32x4*)op = i0; *(u32x4*)(op + 8 * PINP) = i1;
            }
    }
};
struct EpiResid {
    static constexpr bool PERM = true, BMAP = true;
    static constexpr bool NEED_RSTD = false;
    const bf16* hin; bf16* hout; float* rp;
    __device__ __forceinline__ void operator()(const f32x4 (&acc)[2][2][4][2], const Unit& u, int wr, int wc, int fr, int fq, const PG8_LAS float*) const {
        const bool lo = fr < 8; const int rowI = u.pm * BM + wr * 64 + (fr & 7), colI = u.pn * BM + wc * 64 + 32 * (fr >> 3) + 8 * fq;
#pragma unroll
        for (int ai = 0; ai < 2; ++ai) {
            float ssm[4];
#pragma unroll
            for (int m = 0; m < 4; ++m) {
                const size_t off = (size_t)(rowI + ai * HALF + m * 16) * D + colI;
                u32x4 hv0, hv1; xchg8(lo, *(const u32x4*)(hin + off), *(const u32x4*)(hin + off + 8 * D), hv0, hv1);
                const f32x4 a0 = bf4lo(hv0.x, hv0.y) + acc[ai][0][m][0], a1 = bf4lo(hv0.z, hv0.w) + acc[ai][0][m][1], b0 = bf4lo(hv1.x, hv1.y) + acc[ai][1][m][0], b1 = bf4lo(hv1.z, hv1.w) + acc[ai][1][m][1];
                float ss = ((a0.x * a0.x + a0.y * a0.y) + (a0.z * a0.z + a0.w * a0.w)) + ((a1.x * a1.x + a1.y * a1.y) + (a1.z * a1.z + a1.w * a1.w))
                         + ((b0.x * b0.x + b0.y * b0.y) + (b0.z * b0.z + b0.w * b0.w)) + ((b1.x * b1.x + b1.y * b1.y) + (b1.z * b1.z + b1.w * b1.w));
                ss += __shfl_xor(ss, 16); ss += __shfl_xor(ss, 32); ssm[m] = ss;
                u32x4 i0, i1; xchg8(lo, pack8(a0, a1), pack8(b0, b1), i0, i1);
                *(u32x4*)(hout + off) = i0; *(u32x4*)(hout + off + 8 * D) = i1;
            }
            const float sv = fq == 0 ? ssm[0] : (fq == 1 ? ssm[1] : (fq == 2 ? ssm[2] : ssm[3]));
            rp[((size_t)(u.pm * 4 + 2 * ai + wr) * 32 + u.pn * 4 + wc) * 64 + fr + 16 * fq] = sv;
        }
    }
};
struct EpiPoolGate {
    static constexpr bool PERM = true, BMAP = true;
    static constexpr bool NEED_RSTD = false;
    const float* bias; const float* scale; bf16* P; const bf16* ZB;
    __device__ __forceinline__ void operator()(const f32x4 (&acc)[2][2][4][2], const Unit& u, int wr, int wc, int fr, int fq, const PG8_LAS float*) const {
        const bool lo = fr < 8; const int rowI = u.pm * BM + wr * 64 + (fr & 7), colI = u.pn * BM + wc * 64 + 32 * (fr >> 3) + 8 * fq, col0 = u.pn * BM + wc * 64 + 8 * fq;
        f32x4 b[2][2], sc[2][2];
#pragma unroll
        for (int bj = 0; bj < 2; ++bj)
#pragma unroll
            for (int n = 0; n < 2; ++n) { b[bj][n] = *(const f32x4*)(bias + col0 + bj * 32 + 4 * n); sc[bj][n] = *(const f32x4*)(scale + col0 + bj * 32 + 4 * n); }
        const bf16* zp = ZB + ((size_t)((u.pm * (PW / BM) + u.pn) * 8 + wr * 4 + wc) * 16) * 512 + (fq * 16 + fr) * 8;
#pragma unroll
        for (int ai = 0; ai < 2; ++ai)
#pragma unroll
            for (int m = 0; m < 4; ++m) {
                bf16* op = P + (size_t)(rowI + ai * HALF + m * 16) * PINP + colI;
                const u32x4 z0 = *(const u32x4*)(zp + ((ai * 4 + m) * 2 + 0) * 512), z1 = *(const u32x4*)(zp + ((ai * 4 + m) * 2 + 1) * 512);
                const f32x4 v00 = (acc[ai][0][m][0] + b[0][0]) * sc[0][0] * silu4(bf4lo(z0.x, z0.y)), v01 = (acc[ai][0][m][1] + b[0][1]) * sc[0][1] * silu4(bf4lo(z0.z, z0.w));
                const f32x4 v10 = (acc[ai][1][m][0] + b[1][0]) * sc[1][0] * silu4(bf4lo(z1.x, z1.y)), v11 = (acc[ai][1][m][1] + b[1][1]) * sc[1][1] * silu4(bf4lo(z1.z, z1.w));
                u32x4 i0, i1; xchg8(lo, pack8(v00, v01), pack8(v10, v11), i0, i1);
                *(u32x4*)op = i0; *(u32x4*)(op + 8 * PINP) = i1;
            }
    }
};

template <class Epi, class Sched, bool ALIGN_EPI>
__device__ __forceinline__ void gemm_phase(PG8_LAS unsigned char* lds, const Gemm g, const Sched& S, const Epi& E) {
    int tid_ = threadIdx.x; asm volatile("" : "+v"(tid_));
    const int tid = tid_, wid = __builtin_amdgcn_readfirstlane(tid >> 6), lane = tid & 63, wr = wid >> 2, wc = wid & 3, fr = lane & 15, fq = lane >> 4;
    const int K = g.K, nt = K / BK;
    unsigned voffA[2], voffB[2];
#pragma unroll
    for (int i = 0; i < 2; ++i) { int R, C; stage_rc(tid * 16 + i * 8192, R, C);
        const int Rb = Epi::BMAP ? (64 * (R >> 5) + perm32(R & 31)) : (Epi::PERM ? ((R & ~31) + perm32(R & 31)) : R);
        (void)Rb; const int st = wid + 8 * i;
        voffA[i] = (unsigned)(R * g.lda + C) * 2u; voffB[i] = (unsigned)(((st >> 1) * (g.K >> 5) + (st & 1)) * 1024 + lane * 16); }
    const size_t kstep = (size_t)(BK * 2);
    const size_t kstepB = 2048;
    const size_t hsA = (size_t)HALF * g.lda * 2, hsB = (size_t)HALF * g.K * 2;
    const size_t tsA = 2 * hsA, tsB = 2 * hsB;
    const unsigned ldsw = (unsigned)wid * 1024u;
    const int aoff = lds_byte(wr * 64 + fr, fq * 8), boff = lds_byte(wc * 32 + fr, fq * 8);
#define PG8_SA(b, h) (((b) * 2 + (h)) * HTB)
#define PG8_SB(b, h) ((4 + (b) * 2 + (h)) * HTB)
#define PG8_STAGE(bufoff, gbase, voff) do { _Pragma("unroll") for (int _i = 0; _i < 2; ++_i) \
        __builtin_amdgcn_global_load_lds((const unsigned*)((const char*)(gbase) + (voff)[_i]), (PG8_LAS unsigned*)(lds + (bufoff) + ldsw + _i * 8192), 16, 0, 0); } while (0)
#define PG8_LDA(dst, b, h) do { _Pragma("unroll") for (int m = 0; m < 4; ++m) _Pragma("unroll") for (int k = 0; k < 2; ++k) dst[m][k] = *(const PG8_LAS bf16x8*)(lds + PG8_SA(b, h) + aoff + m * 2048 + k * 1024); } while (0)
#define PG8_LDB(dst, b, h) do { _Pragma("unroll") for (int n = 0; n < 2; ++n) _Pragma("unroll") for (int k = 0; k < 2; ++k) dst[n][k] = *(const PG8_LAS bf16x8*)(lds + PG8_SB(b, h) + boff + n * 2048 + k * 1024); } while (0)
#define PG8_MMA(ai, bj, At, Bt) do { __builtin_amdgcn_s_setprio(1); _Pragma("unroll") for (int m = 0; m < 4; ++m) _Pragma("unroll") for (int n = 0; n < 2; ++n) _Pragma("unroll") for (int k = 0; k < 2; ++k) \
        acc[ai][bj][m][n] = __builtin_amdgcn_mfma_f32_16x16x32_bf16(Bt[n][k], At[m][k], acc[ai][bj][m][n], 0, 0, 0); __builtin_amdgcn_s_setprio(0); } while (0)
#define PG8_WAIT_V(n) asm volatile("s_waitcnt vmcnt(" #n ")" ::: "memory")
#define PG8_WAIT_L(n) asm volatile("s_waitcnt lgkmcnt(" #n ")" ::: "memory")
#define PG8_BAR __builtin_amdgcn_s_barrier()
#define PG8_SCHED __builtin_amdgcn_sched_barrier(0)
#define PG8_AKOFF(u) (g.grp_tiles ? (size_t)((u).pn / g.grp_tiles) * (size_t)g.grp_koff * 2 : (size_t)0)
    Unit cur, nxt; int ui = 0, rs_pm = -1;
    if (!S.next(0, cur)) return;
    f32x4 acc[2][2][4][2];
#pragma unroll
    for (int a = 0; a < 2; ++a)
#pragma unroll
        for (int b = 0; b < 2; ++b)
#pragma unroll
            for (int m = 0; m < 4; ++m)
#pragma unroll
                for (int n = 0; n < 2; ++n) acc[a][b][m][n] = (f32x4){0.f, 0.f, 0.f, 0.f};
    bf16x8 At[4][2], B0[2][2], B1[2][2];
    const char* cA = (const char*)g.A + (size_t)cur.pm * tsA + PG8_AKOFF(cur); const char* cB = (const char*)g.Bt + (size_t)cur.pn * tsB;
    PG8_STAGE(PG8_SB(0, 0), cB, voffB); PG8_STAGE(PG8_SB(0, 1), cB + hsB, voffB); PG8_STAGE(PG8_SA(0, 0), cA, voffA); PG8_STAGE(PG8_SA(0, 1), cA + hsA, voffA);
    if (wr == 1) PG8_BAR;
    PG8_WAIT_V(2); PG8_BAR;
    PG8_STAGE(PG8_SB(1, 0), cB + kstepB, voffB); PG8_STAGE(PG8_SA(1, 0), cA + kstep, voffA); PG8_STAGE(PG8_SB(1, 1), cB + hsB + kstepB, voffB);
    PG8_WAIT_V(6); PG8_BAR;
    for (;;) {
        const bool has_next = S.next(ui + 1, nxt);
        const char* nA = has_next ? (const char*)g.A + (size_t)nxt.pm * tsA + PG8_AKOFF(nxt) : cA; const char* nB = has_next ? (const char*)g.Bt + (size_t)nxt.pn * tsB : cB;
        for (int t = 0; t < nt; t += 2) {
            const bool last = (t == nt - 2);
            const char* a1 = cA + (size_t)(t + 1) * kstep;
            const char* a2 = last ? nA : cA + (size_t)(t + 2) * kstep; const char* b2 = last ? nB : cB + (size_t)(t + 2) * kstepB;
            const char* a3 = a2 + kstep; const char* b3 = b2 + kstepB;
            PG8_LDB(B0, 0, 0); PG8_LDB(B1, 0, 1); PG8_SCHED; PG8_LDA(At, 0, 0); PG8_STAGE(PG8_SA(1, 1), a1 + hsA, voffA);
            PG8_WAIT_V(8); PG8_WAIT_L(0); PG8_BAR; PG8_MMA(0, 0, At, B0); PG8_MMA(0, 1, At, B1); PG8_BAR; PG8_SCHED;
            PG8_LDA(At, 0, 1); PG8_STAGE(PG8_SB(0, 0), b2, voffB); PG8_STAGE(PG8_SB(0, 1), b2 + hsB, voffB); PG8_STAGE(PG8_SA(0, 0), a2, voffA);
            PG8_WAIT_V(8); PG8_WAIT_L(0); PG8_BAR; PG8_MMA(1, 0, At, B0); PG8_MMA(1, 1, At, B1); PG8_BAR; PG8_SCHED;
            PG8_LDB(B0, 1, 0); PG8_LDB(B1, 1, 1); PG8_SCHED; PG8_LDA(At, 1, 0); PG8_STAGE(PG8_SA(0, 1), a2 + hsA, voffA);
            PG8_WAIT_V(8); PG8_WAIT_L(0); PG8_BAR; PG8_MMA(0, 0, At, B0); PG8_MMA(0, 1, At, B1); PG8_BAR; PG8_SCHED;
            PG8_LDA(At, 1, 1); PG8_STAGE(PG8_SB(1, 0), b3, voffB); PG8_STAGE(PG8_SB(1, 1), b3 + hsB, voffB); PG8_STAGE(PG8_SA(1, 0), a3, voffA);
            PG8_WAIT_V(8); PG8_WAIT_L(0); PG8_BAR; PG8_MMA(1, 0, At, B0); PG8_MMA(1, 1, At, B1); PG8_BAR; PG8_SCHED;
        }
        if constexpr (ALIGN_EPI) { if (wr == 0) PG8_BAR; }
        const PG8_LAS float* rsl = (const PG8_LAS float*)(lds + STAGE_BYTES);
        if constexpr (Epi::NEED_RSTD) {
            static_assert(ALIGN_EPI, "the table's barrier needs both half-workgroups at the same point");
            if (cur.pm != rs_pm) {
                int t_ = threadIdx.x; asm volatile("" : "+v"(t_));
                const int prow = t_ >> 1; const float* p1 = E.rp + ((size_t)(cur.pm * 4 + (prow >> 6)) * 32 + 16 * (t_ & 1)) * 64 + (prow & 63);
                float pv[16];
#pragma unroll
                for (int k = 0; k < 16; ++k) pv[k] = p1[k * 64];
                float ssum = (((pv[0] + pv[1]) + (pv[2] + pv[3])) + ((pv[4] + pv[5]) + (pv[6] + pv[7]))) + (((pv[8] + pv[9]) + (pv[10] + pv[11])) + ((pv[12] + pv[13]) + (pv[14] + pv[15]))); ssum += __shfl_xor(ssum, 1);
                if (!(t_ & 1)) ((PG8_LAS float*)(lds + STAGE_BYTES))[t_ >> 1] = 1.0f / sqrtf(ssum * (1.0f / (float)D) + EPS);
                PG8_WAIT_L(0); PG8_BAR; asm volatile("" ::: "memory");
                rs_pm = cur.pm;
            }
        }
        { int fr_ = fr, fq_ = fq; asm volatile("" : "+v"(fr_), "+v"(fq_)); E(acc, cur, wr, wc, fr_, fq_, rsl); }
        if (!has_next) break;
#pragma unroll
        for (int a = 0; a < 2; ++a)
#pragma unroll
            for (int b = 0; b < 2; ++b)
#pragma unroll
                for (int m = 0; m < 4; ++m)
#pragma unroll
                    for (int n = 0; n < 2; ++n) acc[a][b][m][n] = (f32x4){0.f, 0.f, 0.f, 0.f};
        cur = nxt; cA = nA; cB = nB; ++ui;
        if constexpr (ALIGN_EPI) { if (wr == 1) PG8_BAR; }
    }
    PG8_WAIT_V(0);
    if constexpr (!ALIGN_EPI) { if (wr == 0) PG8_BAR; }
    PG8_BAR;
#undef PG8_SA
#undef PG8_SB
#undef PG8_STAGE
#undef PG8_LDA
#undef PG8_LDB
#undef PG8_MMA
#undef PG8_WAIT_V
#undef PG8_WAIT_L
#undef PG8_BAR
#undef PG8_SCHED
#undef PG8_AKOFF
}
}

typedef float f32x16 __attribute__((ext_vector_type(16)));
namespace ret {
constexpr int CH = 64, QS = 528, VS = 144;
constexpr int OFF_Q = 0, OFF_K = 32768, KBUF = 32768, OFF_S = 98304, OFF_P = 132096, OFF_VD = 141312, VBUF = 9216, LDS_END = 159744;
#define RET_BAR() do { asm volatile("s_waitcnt lgkmcnt(0)" ::: "memory"); __builtin_amdgcn_s_barrier(); asm volatile("" ::: "memory"); } while (0)
#define RET_MFMA(a, b, c) __builtin_amdgcn_mfma_f32_32x32x16_bf16((a), (b), (c), 0, 0, 0)
__device__ __forceinline__ bf16x8 cat8(u32x2 lo, u32x2 hi) { u32x4 v; v.x = lo.x; v.y = lo.y; v.z = hi.x; v.w = hi.y; return __builtin_bit_cast(bf16x8, v); }
__device__ __forceinline__ int swz(int R) { return ((R & 3) << 2) | ((R >> 2) & 3); }

__device__ __forceinline__ void retention_phase(LAS unsigned char* lds, bf16* P, bf16* Ob, int ldo, float* statp, int vcu, int G) {
    int tid_ = threadIdx.x; asm volatile("" : "+v"(tid_));
    const int tid = tid_, lane = tid & 63, wave = __builtin_amdgcn_readfirstlane(tid >> 6);
    const int r = lane & 31, hh = lane >> 5, blk = (lane >> 4) & 1, q = (lane & 15) >> 2, p = lane & 3;
    const unsigned ldsb = (unsigned)(size_t)lds;
    const int w4 = wave & 3, tb = w4 >> 1, ib = w4 & 1;
    const int fr4 = swz(r);
    const unsigned trK0 = (unsigned)((8 * hh + q) * 512 + (16 * (wave >> 2) + 4 * ((wave & 3) ^ q) + 2 * (blk ^ hh) + ((p >> 1) ^ 0)) * 16 + 8 * (p & 1));
    const unsigned trK1 = (unsigned)((8 * hh + 4 + q) * 512 + (16 * (wave >> 2) + 4 * ((wave & 3) ^ q) + 2 * (blk ^ hh) + ((p >> 1) ^ 1)) * 16 + 8 * (p & 1));
    const unsigned trV = (unsigned)((8 * hh + q) * VS + (16 * blk + 4 * p) * 2);
    unsigned dsrc[4];
#pragma unroll
    for (int k = 0; k < 4; ++k) { const int row = 2 * (4 * wave + k) + (lane >> 5); dsrc[k] = (unsigned)(row * (RV * 2) + (((lane & 31) ^ swz(row)) * 16)); }
#define RET_DMA(GSRC, LOFF) do { _Pragma("unroll") for (int k = 0; k < 4; ++k) \
        __builtin_amdgcn_global_load_lds((const unsigned*)((const char*)(GSRC) + dsrc[k]), (LAS unsigned*)(lds + (LOFF) + (4 * wave + k) * 1024), 16, 0, 0); } while (0)
    for (int u = vcu; u < BATCH * NH * 8; u += G) {
        const int es = u & 7, h = (u >> 3) & 7, b = u >> 6;
        const float lg2 = log2f(1.0f - exp2f(-5.0f - (float)h));
        const size_t rowbase = (size_t)b * SEQ;
        const bf16* gq = P + rowbase * RV + h * 256; const bf16* gk = gq + RQK; const bf16* gv = P + (size_t)M * RV + rowbase * RV + h * 512 + es * 64;
        const float cdecay = exp2f(64.0f * lg2);
        const float kd = exp2f((float)(CH - 1 - (tid >> 3)) * lg2);
        for (int i = tid; i < 33792 / 16; i += 512) *(LAS u32x4*)(lds + OFF_S + i * 16) = (u32x4){0u, 0u, 0u, 0u};
        f32x16 S0, S1;
#pragma unroll
        for (int i = 0; i < 16; ++i) { S0[i] = 0.f; S1[i] = 0.f; }
        const unsigned ov = (unsigned)((tid >> 3) * (RV * 2) + (tid & 7) * 16);
        u32x4 pv = *(const u32x4*)((const char*)gv + ov);
        RET_DMA(gq, OFF_Q); RET_DMA(gk, OFF_K);
        *(LAS u32x4*)(lds + OFF_VD + (tid >> 3) * VS + (tid & 7) * 16) = pg8::pack8(pg8::bf4lo(pv.x, pv.y) * kd, pg8::bf4lo(pv.z, pv.w) * kd);
#pragma unroll 1
        for (int c = 0; c < SEQ / CH; ++c) {
            const int t0 = c * CH; const unsigned vb = (unsigned)(c & 1) * VBUF, kb = (unsigned)(c & 1) * KBUF; const bool more = c + 1 < SEQ / CH;
            asm volatile("s_waitcnt vmcnt(0)" ::: "memory");
            RET_BAR();
            if (more) { RET_DMA(gk + (size_t)(t0 + CH) * RV, OFF_K + KBUF - kb); pv = *(const u32x4*)((const char*)(gv + (size_t)(t0 + CH) * RV) + ov); }
            f32x16 acc;
#pragma unroll
            for (int i = 0; i < 16; ++i) acc[i] = 0.f;
            if (wave < 4) {
                const LAS unsigned char* ap = lds + OFF_S + (32 * tb + r) * QS + 16 * hh; const LAS unsigned char* bp = lds + OFF_Q + (32 * ib + r) * 512;
#pragma unroll
                for (int ks = 0; ks < 16; ++ks) acc = RET_MFMA(*(const LAS bf16x8*)(ap + 32 * ks), *(const LAS bf16x8*)(bp + (((2 * ks + hh) ^ fr4) << 4)), acc);
            } else {
                if (!(tb == 1 && ib == 0)) {
                    const LAS unsigned char* ap = lds + OFF_K + kb + (32 * tb + r) * 512; const LAS unsigned char* bp = lds + OFF_Q + (32 * ib + r) * 512;
#pragma unroll
                    for (int ks = 0; ks < 16; ++ks) { const int co = ((2 * ks + hh) ^ fr4) << 4; acc = RET_MFMA(*(const LAS bf16x8*)(ap + co), *(const LAS bf16x8*)(bp + co), acc); }
                }
                int lo_ = lane; asm volatile("" : "+v"(lo_));
                const int rl = lo_ & 31, hl = lo_ >> 5, il = 32 * ib + rl;
                const float pf = exp2f((float)(il - (CH - 1)) * lg2);
#pragma unroll
                for (int g4 = 0; g4 < 4; ++g4) {
                    float pvv[4];
#pragma unroll
                    for (int e = 0; e < 4; ++e) { const int jl = 32 * tb + 8 * g4 + 4 * hl + e; pvv[e] = (il >= jl) ? acc[4 * g4 + e] * pf : 0.f; }
                    u32x2 w; w.x = pg8::cvt_pk_bf16(pvv[0], pvv[1]); w.y = pg8::cvt_pk_bf16(pvv[2], pvv[3]);
                    *(LAS u32x2*)(lds + OFF_P + il * VS + (32 * tb + 8 * g4 + 4 * hl) * 2) = w;
                }
            }
            RET_BAR();
            if (more) RET_DMA(gq + (size_t)(t0 + CH) * RV, OFF_Q);
            if (wave < 4) {
                const float qd = exp2f((float)(32 * ib + r + 1) * lg2);
#pragma unroll
                for (int i = 0; i < 16; ++i) acc[i] *= qd;
                const LAS unsigned char* bp = lds + OFF_P + (32 * ib + r) * VS + 16 * hh;
                {
                    u32x2 l0, h0, l1, h1, l2, h2, l3, h3; const unsigned a0 = ldsb + OFF_VD + vb + trV + 64 * tb;
                    asm volatile("ds_read_b64_tr_b16 %0, %8\n\tds_read_b64_tr_b16 %1, %8 offset:576\n\tds_read_b64_tr_b16 %2, %8 offset:2304\n\tds_read_b64_tr_b16 %3, %8 offset:2880\n\t"
                                 "ds_read_b64_tr_b16 %4, %8 offset:4608\n\tds_read_b64_tr_b16 %5, %8 offset:5184\n\tds_read_b64_tr_b16 %6, %8 offset:6912\n\tds_read_b64_tr_b16 %7, %8 offset:7488\n\ts_waitcnt lgkmcnt(0)"
                                 : "=&v"(l0), "=&v"(h0), "=&v"(l1), "=&v"(h1), "=&v"(l2), "=&v"(h2), "=&v"(l3), "=&v"(h3) : "v"(a0) : "memory");
                    __builtin_amdgcn_sched_barrier(0);
                    acc = RET_MFMA(cat8(l0, h0), *(const LAS bf16x8*)(bp), acc); acc = RET_MFMA(cat8(l1, h1), *(const LAS bf16x8*)(bp + 32), acc);
                    acc = RET_MFMA(cat8(l2, h2), *(const LAS bf16x8*)(bp + 64), acc); acc = RET_MFMA(cat8(l3, h3), *(const LAS bf16x8*)(bp + 96), acc);
                }
                const size_t row = rowbase + t0 + 32 * ib + r; bf16* op = Ob + row * (size_t)ldo + h * 512 + es * 64 + 32 * tb + 4 * hh;
                float sm = 0.f, sq = 0.f;
#pragma unroll
                for (int g4 = 0; g4 < 4; ++g4) {
                    u32x2 w; w.x = pg8::cvt_pk_bf16(acc[4 * g4], acc[4 * g4 + 1]); w.y = pg8::cvt_pk_bf16(acc[4 * g4 + 2], acc[4 * g4 + 3]);
                    *(u32x2*)(op + 8 * g4) = w;
#pragma unroll
                    for (int e = 0; e < 4; ++e) { const float v = acc[4 * g4 + e]; sm += v; sq += v * v; }
                }
                sm += __shfl_xor(sm, 32); sq += __shfl_xor(sq, 32);
                if (hh == 0) { float* sp = statp + ((row * NH + h) * 16 + 2 * es + tb) * 2; sp[0] = sm; sp[1] = sq; }
            }
#pragma unroll
            for (int i = 0; i < 16; ++i) { S0[i] *= cdecay; S1[i] *= cdecay; }
            {
                const unsigned ka0 = ldsb + OFF_K + kb + trK0, ka1 = ldsb + OFF_K + kb + trK1, va = ldsb + OFF_VD + vb + trV;
#define RET_G2(KOFF, VOFF) do { u32x2 al0, ah0, al1, ah1, p0, p1, p2, p3, p4, p5, p6, p7; \
                asm volatile("ds_read_b64_tr_b16 %0, %12 offset:" #KOFF "\n\tds_read_b64_tr_b16 %1, %13 offset:" #KOFF "\n\tds_read_b64_tr_b16 %2, %12 offset:" #KOFF "+8192\n\tds_read_b64_tr_b16 %3, %13 offset:" #KOFF "+8192\n\t" \
                             "ds_read_b64_tr_b16 %4, %14 offset:" #VOFF "\n\tds_read_b64_tr_b16 %5, %14 offset:" #VOFF "+576\n\tds_read_b64_tr_b16 %6, %14 offset:" #VOFF "+64\n\tds_read_b64_tr_b16 %7, %14 offset:" #VOFF "+640\n\t" \
                             "ds_read_b64_tr_b16 %8, %14 offset:" #VOFF "+2304\n\tds_read_b64_tr_b16 %9, %14 offset:" #VOFF "+2880\n\tds_read_b64_tr_b16 %10, %14 offset:" #VOFF "+2368\n\tds_read_b64_tr_b16 %11, %14 offset:" #VOFF "+2944\n\ts_waitcnt lgkmcnt(0)" \
                             : "=&v"(al0), "=&v"(ah0), "=&v"(al1), "=&v"(ah1), "=&v"(p0), "=&v"(p1), "=&v"(p2), "=&v"(p3), "=&v"(p4), "=&v"(p5), "=&v"(p6), "=&v"(p7) : "v"(ka0), "v"(ka1), "v"(va) : "memory"); \
                __builtin_amdgcn_sched_barrier(0); \
                { const bf16x8 a0 = cat8(al0, ah0), a1 = cat8(al1, ah1); \
                  S0 = RET_MFMA(a0, cat8(p0, p1), S0); S1 = RET_MFMA(a0, cat8(p2, p3), S1); S0 = RET_MFMA(a1, cat8(p4, p5), S0); S1 = RET_MFMA(a1, cat8(p6, p7), S1); } } while (0)
                RET_G2(0, 0); RET_G2(16384, 4608);
#undef RET_G2
            }
#pragma unroll
            for (int g4 = 0; g4 < 4; ++g4) {
                u32x2 w0, w1; w0.x = pg8::cvt_pk_bf16(S0[4 * g4], S0[4 * g4 + 1]); w0.y = pg8::cvt_pk_bf16(S0[4 * g4 + 2], S0[4 * g4 + 3]);
                w1.x = pg8::cvt_pk_bf16(S1[4 * g4], S1[4 * g4 + 1]); w1.y = pg8::cvt_pk_bf16(S1[4 * g4 + 2], S1[4 * g4 + 3]);
                *(LAS u32x2*)(lds + OFF_S + r * QS + (32 * wave + 8 * g4 + 4 * hh) * 2) = w0;
                *(LAS u32x2*)(lds + OFF_S + (32 + r) * QS + (32 * wave + 8 * g4 + 4 * hh) * 2) = w1;
            }
            if (more) *(LAS u32x4*)(lds + OFF_VD + (VBUF - vb) + (tid >> 3) * VS + (tid & 7) * 16) = pg8::pack8(pg8::bf4lo(pv.x, pv.y) * kd, pg8::bf4lo(pv.z, pv.w) * kd);
        }
        asm volatile("s_waitcnt vmcnt(0)" ::: "memory");
        RET_BAR();
    }
#undef RET_DMA
}
#undef RET_BAR
#undef RET_MFMA
}

constexpr int NWAVES = 8;
constexpr int RING_OFF = 0, RING_BYTES = 159744;
constexpr int LDSCTL_OFF = RING_BYTES, MISC_OFF = LDSCTL_OFF + 320;
constexpr int LDS_BYTES = 160768;
static_assert(ret::LDS_END <= RING_BYTES && pg8::STAGE_BYTES <= RING_BYTES, "LDS map");
constexpr int CW_BAR = 4096;
constexpr int N_PHASES = 18;

#define GAS __attribute__((address_space(1)))
typedef GAS unsigned gu32;
#define RLX_AGENT __ATOMIC_RELAXED, __HIP_MEMORY_SCOPE_AGENT

#define XB_TMO      128
#define XB_XCNT(j)  (256  + 64 * (j))
#define XB_XSUB(j)  (1280 + 64 * (j))
#define XB_XGEN(j)  (2304 + 64 * (j))
#define XB_TOP      3328
#define XB_TOPGEN   3392
#define XCD_BAR_WORDS 3456
#define XB_SPIN_CAP (1u << 18)

__device__ __forceinline__ unsigned xb_ld(unsigned* p)              { return __hip_atomic_load(p, __ATOMIC_RELAXED, __HIP_MEMORY_SCOPE_AGENT); }
__device__ __forceinline__ unsigned xb_add(unsigned* p, unsigned v) { return __hip_atomic_fetch_add(p, v, __ATOMIC_RELAXED, __HIP_MEMORY_SCOPE_AGENT); }
__device__ __forceinline__ unsigned xb_xcc_id() { return (unsigned)__builtin_amdgcn_s_getreg((3 << 11) | 20) & 0xFu; }
#define XB_SPIN(cond, bar) do { unsigned _sp = 0; while (cond) { __builtin_amdgcn_s_sleep(1); \
    if ((++_sp & 255u) == 0u) { if (xb_ld(&(bar)[XB_TMO])) break; if (_sp > XB_SPIN_CAP) { atomicAdd(&(bar)[XB_TMO], 1u); break; } } } } while (0)

struct XcdBarrier { unsigned* bar; unsigned x; volatile LAS unsigned* st; };
__device__ __forceinline__ XcdBarrier xcd_barrier_post(unsigned* bar, volatile LAS unsigned* st) {
    XcdBarrier b; b.bar = bar; b.x = xb_xcc_id(); b.st = st;
    if (threadIdx.x == 0) (void)xb_add(&bar[XB_XCNT(b.x)], 1u);
    return b;
}
__device__ __forceinline__ void xcd_barrier_complete(unsigned* bar, unsigned x, unsigned& nloc, unsigned& nx) {
    const unsigned G = gridDim.x * gridDim.y * gridDim.z;
    unsigned sum, cnt, mine, sp = 0u;
    for (;;) {
        sum = 0u; cnt = 0u; mine = 0u;
#pragma unroll
        for (unsigned j = 0; j < 16; ++j) { const unsigned c = xb_ld(&bar[XB_XCNT(j)]); sum += c; cnt += (c > 0u) ? 1u : 0u; mine = (j == x) ? c : mine; }
        if (sum == G) break;
        __builtin_amdgcn_s_sleep(1);
        if ((++sp & 255u) == 0u) { if (xb_ld(&bar[XB_TMO])) break; if (sp > XB_SPIN_CAP) { atomicAdd(&bar[XB_TMO], 1u); break; } }
    }
    nloc = mine > 0u ? mine : 1u; nx = cnt > 0u ? cnt : 1u;
}
__device__ __forceinline__ void xcd_barrier(const XcdBarrier& b) {
    asm volatile("s_waitcnt vmcnt(0)" ::: "memory");
    __syncthreads();
    if (threadIdx.x == 0) {
        unsigned* bar = b.bar;
        __builtin_amdgcn_s_waitcnt(0);
        unsigned nloc = b.st[0], nx = b.st[1];
        if (nloc == 0u) { xcd_barrier_complete(bar, b.x, nloc, nx); b.st[0] = nloc; b.st[1] = nx; }
        const unsigned old = xb_add(&bar[XB_XSUB(b.x)], 1u);
        const unsigned gen = old / nloc;
        if (old + 1u == (gen + 1u) * nloc) {
            __builtin_amdgcn_fence(__ATOMIC_RELEASE, "agent");
            asm volatile("s_waitcnt vmcnt(0)" ::: "memory");
            const unsigned og = xb_add(&bar[XB_TOP], 1u);
            const unsigned tg = og / nx;
            if (og + 1u == (tg + 1u) * nx) xb_add(&bar[XB_TOPGEN], 1u);
            else XB_SPIN(xb_ld(&bar[XB_TOPGEN]) == tg, bar);
            __builtin_amdgcn_fence(__ATOMIC_ACQUIRE, "agent");
            xb_add(&bar[XB_XGEN(b.x)], 1u);
            asm volatile("s_waitcnt vmcnt(0)" ::: "memory");
        } else {
            XB_SPIN(xb_ld(&bar[XB_XGEN(b.x)]) == gen, bar);
            __builtin_amdgcn_fence(__ATOMIC_ACQUIRE, "agent");
            asm volatile("s_waitcnt vmcnt(0)" ::: "memory");
        }
    }
    __syncthreads();
}

struct Args {
    const float *x, *ret_norm, *ret_w_in, *ret_gn, *ret_w_out, *pool_norm, *pool_w_in, *pool_w_grp, *pool_b_grp, *pool_scale, *pool_w_out, *final_norm;
    float* out; unsigned char* ws; int ph_lo, ph_hi, li, pad;
};

__device__ __forceinline__ void gate_phase(bf16* P, bf16* Ob, int ldo, const float* statp, const float* gn, int gw, int NGW, int lane) {
    for (int blk = gw; blk < (M / 8) * NH; blk += NGW) {
        const int h = blk & 7; const size_t row0 = (size_t)(blk >> 3) * 8;
        float st[8]; u32x4 ov[8], zv[8];
#pragma unroll
        for (int i = 0; i < 8; ++i) {
            st[i] = (lane < 32) ? statp[((row0 + i) * NH + h) * 32 + lane] : 0.f;
            const bf16* op = P + (size_t)M * RV + (row0 + i) * RV + h * 512 + lane * 8;
            ov[i] = *(const u32x4*)op; zv[i] = *(const u32x4*)(op + (size_t)M * RV);
        }
        const f32x4 g0 = *(const f32x4*)(gn + h * 512 + lane * 8), g1 = *(const f32x4*)(gn + h * 512 + lane * 8 + 4);
#pragma unroll
        for (int i = 0; i < 8; ++i) {
            float v = st[i];
#pragma unroll
            for (int o = 2; o < 32; o <<= 1) v += __shfl_xor(v, o);
            const float sm = __shfl(v, 0), sq = __shfl(v, 1);
            const float mu = sm * (1.0f / 512.f), var = fmaxf(sq * (1.0f / 512.f) - mu * mu, 0.f), rs = 1.0f / sqrtf(var + EPS);
            const f32x4 o0 = (pg8::bf4lo(ov[i].x, ov[i].y) - mu) * rs * g0 * pg8::silu4(pg8::bf4lo(zv[i].x, zv[i].y)), o1 = (pg8::bf4lo(ov[i].z, ov[i].w) - mu) * rs * g1 * pg8::silu4(pg8::bf4lo(zv[i].z, zv[i].w));
            *(u32x4*)(Ob + (row0 + i) * (size_t)ldo + h * 512 + lane * 8) = pg8::pack8(o0, o1);
        }
    }
}
template <int W> __device__ __forceinline__ void mix_block(const bf16* P, bf16* MIX, size_t row0, int t0, int c) {
    constexpr int NR = W - 1 + 16;
    u32x4 v[NR];
    const bf16* up = P + row0 * PINP + c;
    if (t0 == 0) {
#pragma unroll
        for (int k = 0; k < W - 1; ++k) v[k] = (u32x4){0u, 0u, 0u, 0u};
    } else {
#pragma unroll
        for (int k = 0; k < W - 1; ++k) v[k] = *(const u32x4*)(up - (size_t)(W - 1 - k) * PINP);
    }
#pragma unroll
    for (int k = 0; k < 16; ++k) v[W - 1 + k] = *(const u32x4*)(up + (size_t)k * PINP);
    f32x4 s0 = (f32x4){0.f, 0.f, 0.f, 0.f}, s1 = s0;
#pragma unroll
    for (int k = 0; k < W - 1; ++k) { s0 += pg8::bf4lo(v[k].x, v[k].y); s1 += pg8::bf4lo(v[k].z, v[k].w); }
#pragma unroll
    for (int r = 0; r < 16; ++r) {
        const f32x4 u0 = pg8::bf4lo(v[W - 1 + r].x, v[W - 1 + r].y), u1 = pg8::bf4lo(v[W - 1 + r].z, v[W - 1 + r].w);
        s0 += u0; s1 += u1;
        const int n = (t0 + r + 1 < W) ? t0 + r + 1 : W; const float inv = 1.0f / (float)n;
        *(u32x4*)(MIX + (row0 + r) * PW + c) = pg8::pack8(s0 * inv - u0, s1 * inv - u1);
        s0 -= pg8::bf4lo(v[r].x, v[r].y); s1 -= pg8::bf4lo(v[r].z, v[r].w);
    }
}
__device__ __forceinline__ void mix_phase(const bf16* P, bf16* MIX, int gw, int NGW, int lane) {
    for (int it = gw; it < (M / 16) * 8; it += NGW) {
        const int rb = it >> 3, c = ((it & 7) * 64 + lane) * 8, g = (it & 7) >> 1; const size_t row0 = (size_t)rb * 16; const int t0 = (int)(row0 & (SEQ - 1));
        if (g == 0) mix_block<2>(P, MIX, row0, t0, c); else if (g == 1) mix_block<4>(P, MIX, row0, t0, c); else if (g == 2) mix_block<8>(P, MIX, row0, t0, c); else mix_block<16>(P, MIX, row0, t0, c);
    }
}
__device__ __forceinline__ void final_phase(const bf16* h, float* o, const float* rp, const float* g, int gw, int NGW, int lane) {
    for (int row = 4 * gw; row < M; row += 4 * NGW) {
        u32x4 v[4][4]; float s[4];
#pragma unroll
        for (int i = 0; i < 4; ++i) { s[i] = (lane < 32) ? rp[((size_t)((row + i) >> 6) * 32 + lane) * 64 + ((row + i) & 63)] : 0.f;
#pragma unroll
            for (int j = 0; j < 4; ++j) v[i][j] = *((const u32x4*)(h + (size_t)(row + i) * D) + lane + 64 * j); }
        f32x4 gg[4][2];
#pragma unroll
        for (int j = 0; j < 4; ++j) { gg[j][0] = *((const f32x4*)g + 2 * (lane + 64 * j)); gg[j][1] = *((const f32x4*)g + 2 * (lane + 64 * j) + 1); }
#pragma unroll
        for (int i = 0; i < 4; ++i) { const float rs = 1.0f / sqrtf(wave_sum(s[i]) * (1.0f / (float)D) + EPS);
#pragma unroll
            for (int j = 0; j < 4; ++j) { f32x4* op = (f32x4*)(o + (size_t)(row + i) * D) + 2 * (lane + 64 * j);
                op[0] = pg8::bf4lo(v[i][j].x, v[i][j].y) * rs * gg[j][0]; op[1] = pg8::bf4lo(v[i][j].z, v[i][j].w) * rs * gg[j][1]; } }
    }
}
struct WSeg { const float* src; bf16* dst; const float* g; int K, N, nmat; };
__device__ __forceinline__ void prologue_phase(const __attribute__((address_space(4))) Args* ka, LAS unsigned char* lds, int gw, int NGW, int wave, int lane) {
    const __attribute__((address_space(4))) Args* ap = ka; asm volatile("" : "+s"(ap));
    LAS float* scr = (LAS float*)(lds + RING_OFF + wave * 16384);
    unsigned char* ws = ap->ws;
#pragma unroll 1
    for (int s = 0; s < 5; ++s) {
        WSeg sg;
        if (s == 0) sg = WSeg{ap->ret_w_in, (bf16*)(ws + WS_W_RIN), ap->ret_norm, D, RIN, 2};
        else if (s == 1) sg = WSeg{ap->ret_w_out, (bf16*)(ws + WS_W_ROUT), nullptr, RV, D, 2};
        else if (s == 2) sg = WSeg{ap->pool_w_in, (bf16*)(ws + WS_W_PIN), ap->pool_norm, D, PIN, 2};
        else if (s == 3) sg = WSeg{ap->pool_w_grp, (bf16*)(ws + WS_W_PGRP), nullptr, PGD, PGD, 8};
        else sg = WSeg{ap->pool_w_out, (bf16*)(ws + WS_W_POUT), nullptr, PW, D, 2};
        const int ipm = (sg.K / 64) * (sg.N / 32), total = ipm * sg.nmat;
        for (int it = gw; it < total; it += NGW) { const int mi = it / ipm, r = it % ipm;
            transpose_item(sg.src + (size_t)mi * sg.K * sg.N, sg.K, sg.N, sg.dst + (size_t)mi * sg.K * sg.N, scr, r, lane, sg.g ? sg.g + (size_t)mi * sg.K : nullptr, s != 0); }
    }
    bf16* hb = (bf16*)(ws + WS_HB); float* rp0 = (float*)(ws + WS_RP);
    for (int m = 2 * gw; m < M; m += 2 * NGW) {
        f32x4 v[2][8];
#pragma unroll
        for (int i = 0; i < 2; ++i)
#pragma unroll
            for (int j = 0; j < 8; ++j) v[i][j] = *((const f32x4*)(ap->x + (size_t)(m + i) * D) + lane + 64 * j);
#pragma unroll
        for (int i = 0; i < 2; ++i) { float s = 0.f; u32x2* o8 = (u32x2*)(hb + (size_t)(m + i) * D) + lane;
#pragma unroll
            for (int j = 0; j < 8; ++j) { const f32x4 x4 = v[i][j]; s += (x4.x * x4.x + x4.y * x4.y) + (x4.z * x4.z + x4.w * x4.w);
                u32x2 w; w.x = pg8::cvt_pk_bf16(x4.x, x4.y); w.y = pg8::cvt_pk_bf16(x4.z, x4.w); o8[64 * j] = w; }
            s = wave_sum(s);
            if (lane < 32) rp0[((size_t)((m + i) >> 6) * 32 + lane) * 64 + ((m + i) & 63)] = lane == 0 ? s : 0.f; }
    }
    float* cosT = (float*)(ws + WS_COS); float* sinT = (float*)(ws + WS_SIN);
    {
        const int i0 = gw * 64 + lane; const float inv = powf(10000.0f, -(float)(i0 & 127) / 128.0f);
        for (int i = i0; i < SEQ * 128; i += NGW * 64) { float sn, cs; sincosf((float)(i >> 7) * inv, &sn, &cs); cosT[i] = cs; sinT[i] = sn; }
    }
}

#define KA_T const __attribute__((address_space(4))) Args
#define SITE_ARGS(a) KA_T* a = ka0; asm volatile("" : "+s"(a))
__global__ void __launch_bounds__(NWAVES * 64, 2) mega(Args args_unused) {
    extern __shared__ __attribute__((aligned(16))) unsigned char lds_raw[];
    LAS unsigned char* lds = (LAS unsigned char*)lds_raw;
    KA_T* ka0 = (KA_T*)__builtin_amdgcn_kernarg_segment_ptr();
    const int wave = __builtin_amdgcn_readfirstlane((int)threadIdx.x >> 6);
    const int G = gridDim.x, gw = blockIdx.x * NWAVES + wave, NGW = G * NWAVES;
    const int vcu = (G % 8 == 0) ? (int)(blockIdx.x % 8) * (G / 8) + (int)(blockIdx.x / 8) : (int)blockIdx.x;
    for (int u = threadIdx.x; u < (LDS_BYTES - LDSCTL_OFF) / 4; u += NWAVES * 64) ((LAS unsigned*)(lds + LDSCTL_OFF))[u] = 0u;
    __syncthreads();
    unsigned phmask; XcdBarrier bar;
    { SITE_ARGS(a); const int lo = a->ph_lo, hi = a->ph_hi;
      phmask = __builtin_amdgcn_readfirstlane((unsigned)(((1ull << hi) - 1ull) & ~((1ull << lo) - 1ull)));
      unsigned* bw = (unsigned*)(a->ws + WS_CTL) + CW_BAR + a->li * XCD_BAR_WORDS;
      bar.bar = bw; bar.x = 0; bar.st = nullptr;
      if (hi - lo > 1) bar = xcd_barrier_post(bw, (volatile LAS unsigned*)(lds + MISC_OFF) + 8); }
#define IN(k) ((phmask >> (k)) & 1u)
#define SEAM(k) do { if ((phmask >> (k)) & (phmask >> ((k) + 1)) & 1u) xcd_barrier(bar); } while (0)
#define LANE() ({ int t_ = threadIdx.x; asm volatile("" : "+v"(t_)); t_ & 63; })

    if (IN(0)) { prologue_phase(ka0, lds, gw, NGW, wave, LANE()); SEAM(0); }

#pragma unroll 1
    for (int lp = 0; lp < 2; ++lp) {
        const int pb = 1 + 8 * lp;
        if (IN(pb + 0)) {
            SITE_ARGS(a); unsigned char* ws = a->ws;
            pg8::Gemm g{(const bf16*)(ws + WS_HB), (const bf16*)(ws + WS_W_RIN) + (size_t)lp * D * RIN, M, RIN, D, D, D, 0, 0}; pg8::StaticOrder S; S.init(M, RIN, G, (int)blockIdx.x);
            pg8::EpiRetIn E{ws, (const float*)(ws + WS_RP + (size_t)(2 * lp) * RP_STRIDE)};
            pg8::gemm_phase<pg8::EpiRetIn, pg8::StaticOrder, true>(lds + RING_OFF, g, S, E);

            SEAM(pb + 0);
        }
        if (IN(pb + 1)) { SITE_ARGS(a); unsigned char* ws = a->ws; ret::retention_phase(lds + RING_OFF, (bf16*)(ws + WS_P), (bf16*)(ws + WS_P) + (size_t)M * RV, RV, (float*)(ws + WS_ST), vcu, G); SEAM(pb + 1); }
        if (IN(pb + 2)) { SITE_ARGS(a); unsigned char* ws = a->ws; gate_phase((bf16*)(ws + WS_P), (bf16*)(ws + WS_P) + (size_t)M * RV, RV, (const float*)(ws + WS_ST), a->ret_gn + (size_t)lp * RV, gw, NGW, LANE()); SEAM(pb + 2); }
        if (IN(pb + 3)) {
            SITE_ARGS(a); unsigned char* ws = a->ws;
            pg8::Gemm g{(const bf16*)(ws + WS_P) + (size_t)M * RV, (const bf16*)(ws + WS_W_ROUT) + (size_t)lp * RV * D, M, D, RV, RV, RV, 0, 0}; pg8::StaticOrder S; S.init(M, D, G, (int)blockIdx.x);
            pg8::EpiResid E{(const bf16*)(ws + WS_HB), (bf16*)(ws + WS_HB), (float*)(ws + WS_RP + (size_t)(2 * lp + 1) * RP_STRIDE)};
            pg8::gemm_phase<pg8::EpiResid, pg8::StaticOrder, true>(lds + RING_OFF, g, S, E);

            SEAM(pb + 3);
        }
        if (IN(pb + 4)) {
            SITE_ARGS(a); unsigned char* ws = a->ws;
            pg8::Gemm g{(const bf16*)(ws + WS_HB), (const bf16*)(ws + WS_W_PIN) + (size_t)lp * D * PIN, M, PIN, D, D, D, 0, 0}; pg8::StaticOrder S; S.init(M, PIN, G, (int)blockIdx.x);
            pg8::EpiPoolIn E{(bf16*)(ws + WS_P), (bf16*)(ws + WS_ZB), (const float*)(ws + WS_RP + (size_t)(2 * lp + 1) * RP_STRIDE)};
            pg8::gemm_phase<pg8::EpiPoolIn, pg8::StaticOrder, true>(lds + RING_OFF, g, S, E);

            SEAM(pb + 4);
        }
        if (IN(pb + 5)) { SITE_ARGS(a); unsigned char* ws = a->ws; mix_phase((const bf16*)(ws + WS_P), (bf16*)(ws + WS_MIX), gw, NGW, LANE()); SEAM(pb + 5); }
        if (IN(pb + 6)) {
            SITE_ARGS(a); unsigned char* ws = a->ws;
            pg8::Gemm g{(const bf16*)(ws + WS_MIX), (const bf16*)(ws + WS_W_PGRP) + (size_t)lp * PG * PGD * PGD, M, PW, PGD, PW, PGD, PGD / 256, PGD}; pg8::StaticOrder S; S.init(M, PW, G, (int)blockIdx.x);
            pg8::EpiPoolGate E{a->pool_b_grp + (size_t)lp * PW, a->pool_scale + (size_t)lp * PW, (bf16*)(ws + WS_P), (const bf16*)(ws + WS_ZB)};
            pg8::gemm_phase<pg8::EpiPoolGate, pg8::StaticOrder, true>(lds + RING_OFF, g, S, E);

            SEAM(pb + 6);
        }
        if (IN(pb + 7)) {
            SITE_ARGS(a); unsigned char* ws = a->ws;
            pg8::Gemm g{(const bf16*)(ws + WS_P), (const bf16*)(ws + WS_W_POUT) + (size_t)lp * PW * D, M, D, PW, PINP, PW, 0, 0}; pg8::StaticOrder S; S.init(M, D, G, (int)blockIdx.x);
            pg8::EpiResid E{(const bf16*)(ws + WS_HB), (bf16*)(ws + WS_HB), (float*)(ws + WS_RP + (size_t)(2 * lp + 2) * RP_STRIDE)};
            pg8::gemm_phase<pg8::EpiResid, pg8::StaticOrder, true>(lds + RING_OFF, g, S, E);

            SEAM(pb + 7);
        }
    }
    if (IN(17)) { SITE_ARGS(a); final_phase((const bf16*)(a->ws + WS_HB), a->out, (const float*)(a->ws + WS_RP + 4 * RP_STRIDE), a->final_norm, gw, NGW, LANE()); }
#undef IN
#undef SEAM
}

extern "C" void kernel_launch(void* const* d_in, const int* in_sizes, int n_in, void* d_out, int out_size, void* d_ws, size_t ws_size, hipStream_t stream) {
    static int grid = 0;
    if (grid == 0) {
        if (n_in != 12 || out_size != M * D || ws_size < WS_END) { fprintf(stderr, "kernel_launch: unexpected shapes / workspace (%d inputs, out %d, ws %zu)\n", n_in, out_size, ws_size); grid = -1; return; }
        int dev = 0, cus = 0, per_cu = 0;
        if (hipGetDevice(&dev) != hipSuccess || hipDeviceGetAttribute(&cus, hipDeviceAttributeMultiprocessorCount, dev) != hipSuccess) { grid = -1; return; }
        if (hipFuncSetAttribute((const void*)mega, hipFuncAttributeMaxDynamicSharedMemorySize, LDS_BYTES) != hipSuccess) { fprintf(stderr, "kernel_launch: hipFuncSetAttribute failed\n"); grid = -1; return; }
        if (hipOccupancyMaxActiveBlocksPerMultiprocessor(&per_cu, (const void*)mega, NWAVES * 64, LDS_BYTES) != hipSuccess || per_cu < 1) {
            fprintf(stderr, "kernel_launch: the occupancy query reports %d workgroups per CU for the persistent kernel; nothing launched\n", per_cu); (void)hipGetLastError(); grid = -1; return; }
        grid = cus;
    }
    if (grid < 0) return;
    (void)hipMemsetAsync((unsigned char*)d_ws + WS_CTL, 0, 32768, stream);
    Args a{};
    a.x = (const float*)d_in[0]; a.ret_norm = (const float*)d_in[1]; a.ret_w_in = (const float*)d_in[2]; a.ret_gn = (const float*)d_in[3]; a.ret_w_out = (const float*)d_in[4];
    a.pool_norm = (const float*)d_in[5]; a.pool_w_in = (const float*)d_in[6]; a.pool_w_grp = (const float*)d_in[7]; a.pool_b_grp = (const float*)d_in[8]; a.pool_scale = (const float*)d_in[9];
    a.pool_w_out = (const float*)d_in[10]; a.final_norm = (const float*)d_in[11]; a.out = (float*)d_out; a.ws = (unsigned char*)d_ws;
    a.ph_lo = 0; a.ph_hi = N_PHASES; a.li = 0; a.pad = 0;
    hipLaunchKernelGGL(mega, dim3(grid), dim3(NWAVES * 64), LDS_BYTES, stream, a);
}
```
